# Optimizing an MI355X kernel written in HIP

```python
import jax, jax.numpy as jnp
from jax import lax
import numpy as np

D_MODEL = 1024
BATCH = 4
SEQ = 8192
DEPTH = 1
DEC_BATCH = 8
DEC_SEQ = 4096
PAST_LEN = 128

D_RNN = D_MODEL
RG_BLOCKS = 16
RG_BW = D_RNN // RG_BLOCKS
RG_C = 8.0
CONV_W = 4
CONV_LEFT = 2
HEAD_DIM = 64
HEADS_PER_GROUP = 8
ATT_GROUPS = ((128, 1), (512, 4), (2048, 16))
N_GROUPS = len(ATT_GROUPS)
ATT_W = N_GROUPS * HEADS_PER_GROUP * HEAD_DIM
ATT_OUT = HEADS_PER_GROUP * HEAD_DIM
ATT_BLOCK = 64
ROT_DIM = HEAD_DIM // 4
ROPE_THETA = 500000.0
D_FF = ((-(-8 * D_MODEL // 3) + 255) // 256) * 256
N_MOD = 6
EPS = 1e-6
NEG_INF = -1e30
IN_SPLITS = (D_RNN, 2 * D_RNN, 2 * D_RNN + ATT_W, 2 * D_RNN + 2 * ATT_W, 2 * D_RNN + 3 * ATT_W)
IN_COLS = 2 * D_RNN + 3 * ATT_W + 2 * D_MODEL

kernel_name = 'griffin_dilated_window_adaln_encoder'


def _rmsnorm(x, g):
    xf = x.astype(jnp.float32)
    y = xf * lax.rsqrt(jnp.mean(xf * xf, axis=-1, keepdims=True) + EPS)
    return (y * g.astype(jnp.float32)).astype(x.dtype)


def _rope(x):
    S = x.shape[1]
    half = ROT_DIM // 2
    inv = ROPE_THETA ** (-(jnp.arange(0, ROT_DIM, 2, dtype=jnp.float32) / ROT_DIM))
    ang = jnp.arange(S, dtype=jnp.float32)[:, None] * inv[None, :]
    cos = jnp.cos(ang)[None, :, None, None, :]
    sin = jnp.sin(ang)[None, :, None, None, :]
    xf = x.astype(jnp.float32)
    x1 = xf[..., :half]
    x2 = xf[..., half:ROT_DIM]
    out = jnp.concatenate([x1 * cos - x2 * sin, x2 * cos + x1 * sin, xf[..., ROT_DIM:]], axis=-1)
    return out.astype(x.dtype)


def _centred_dwconv(x, w, b):
    S = x.shape[1]
    xp = jnp.pad(x, ((0, 0), (CONV_LEFT, CONV_W - 1 - CONV_LEFT), (0, 0)))
    y = b[None, None, :] + xp[:, 0:S] * w[0]
    for k in range(1, CONV_W):
        y = y + xp[:, k:k + S] * w[k]
    return y


def _rglru(xc, wa, ba, wx, bx, lam, reverse):
    B, S, _ = xc.shape
    xf = xc.astype(jnp.float32)
    xb = xf.reshape(B, S, RG_BLOCKS, RG_BW)
    r = jax.nn.sigmoid(jnp.einsum('bsnc,ncd->bsnd', xb, wa.astype(jnp.float32)) + ba.astype(jnp.float32)).reshape(B, S, D_RNN)
    i = jax.nn.sigmoid(jnp.einsum('bsnc,ncd->bsnd', xb, wx.astype(jnp.float32)) + bx.astype(jnp.float32)).reshape(B, S, D_RNN)
    log_a = -RG_C * r * jax.nn.softplus(-lam.astype(jnp.float32))
    a = jnp.exp(log_a)
    u = jnp.sqrt(-jnp.expm1(2.0 * log_a)) * (i * xf)

    def comb(e1, e2):
        a1, b1 = e1
        a2, b2 = e2
        return a1 * a2, a2 * b1 + b2

    _, h = lax.associative_scan(comb, (a, u), reverse=reverse, axis=1)
    return h


def _dilated_window_attention(q, k, v, dil, radius):
    B, S, H, E = q.shape
    L = S // dil
    nb = -(-L // ATT_BLOCK)
    Lp = nb * ATT_BLOCK

    def fold(t):
        t = t.reshape(B, L, dil, H, E)
        return jnp.pad(t, ((0, 0), (0, Lp - L), (0, 0), (0, 0), (0, 0)))

    def windows(t):
        tp = jnp.pad(fold(t), ((0, 0), (ATT_BLOCK, ATT_BLOCK), (0, 0), (0, 0), (0, 0)))
        tp = tp.reshape(B, nb + 2, ATT_BLOCK, dil, H, E)
        return jnp.concatenate([tp[:, :-2], tp[:, 1:-1], tp[:, 2:]], axis=2)

    qf = fold(q).reshape(B, nb, ATT_BLOCK, dil, H, E)
    kw = windows(k)
    vw = windows(v)
    s = jnp.einsum('bnqrhe,bnkrhe->bnrhqk', qf, kw, preferred_element_type=jnp.float32) * (HEAD_DIM ** -0.5)
    blk = jnp.arange(nb)[:, None, None]
    mq = blk * ATT_BLOCK + jnp.arange(ATT_BLOCK)[None, :, None]
    mk = (blk - 1) * ATT_BLOCK + jnp.arange(3 * ATT_BLOCK)[None, None, :]
    valid = (jnp.abs(mq - mk) <= radius) & (mk >= 0) & (mk < L)
    s = jnp.where(valid[None, :, None, None, :, :], s, NEG_INF)
    lse = jax.nn.logsumexp(s, axis=-1)
    p = jnp.exp(s - lse[..., None])
    o = jnp.einsum('bnrhqk,bnkrhe->bnqrhe', p, vw.astype(jnp.float32))
    o = o.reshape(B, Lp, dil, H, E)[:, :L].reshape(B, S, H, E)
    lse = lse.transpose(0, 1, 4, 2, 3).reshape(B, Lp, dil, H)[:, :L].reshape(B, S, H)
    return o, lse


def _layer(x, c, w_ada, b_ada, norm1_g, w_in, conv_w, conv_b, rg_wa, rg_ba, rg_wx, rg_bx, rg_lambda,
           w_br_rnn, w_br_attn, w_out, norm2_g, w_ffn_in, w_ffn_out):
    B, S, _ = x.shape
    mod = jax.nn.silu(c.astype(jnp.float32)) @ w_ada.astype(jnp.float32) + b_ada.astype(jnp.float32)
    sh1, sc1, gt1, sh2, sc2, gt2 = jnp.split(mod, N_MOD, axis=-1)

    h = (_rmsnorm(x, norm1_g) * (1.0 + sc1[:, None]) + sh1[:, None]).astype(x.dtype)
    z = h @ w_in
    xr, gr, q, k, v, mg = jnp.split(z, IN_SPLITS, axis=-1)

    xc = _centred_dwconv(xr, conv_w, conv_b)
    rec = _rglru(xc, rg_wa[0], rg_ba[0], rg_wx[0], rg_bx[0], rg_lambda[0], False) \
        + _rglru(xc, rg_wa[1], rg_ba[1], rg_wx[1], rg_bx[1], rg_lambda[1], True)
    rnn_out = (rec * jax.nn.gelu(gr.astype(jnp.float32), approximate=True)).astype(x.dtype)

    q = _rope(q.reshape(B, S, N_GROUPS, HEADS_PER_GROUP, HEAD_DIM))
    k = _rope(k.reshape(B, S, N_GROUPS, HEADS_PER_GROUP, HEAD_DIM))
    v = v.reshape(B, S, N_GROUPS, HEADS_PER_GROUP, HEAD_DIM)
    outs = []
    lses = []
    for g, (win, dil) in enumerate(ATT_GROUPS):
        o_g, lse_g = _dilated_window_attention(q[:, :, g], k[:, :, g], v[:, :, g], dil, (win // 2) // dil)
        outs.append(o_g)
        lses.append(lse_g)
    wts = jax.nn.softmax(jnp.stack(lses, axis=0), axis=0)
    att = jnp.einsum('gbsh,gbshe->bshe', wts, jnp.stack(outs, axis=0))
    att_out = att.reshape(B, S, ATT_OUT).astype(x.dtype)

    gate_r, gate_a = jnp.split(jax.nn.sigmoid(mg.astype(jnp.float32)), 2, axis=-1)
    merged = gate_r * (rnn_out @ w_br_rnn) + gate_a * (att_out @ w_br_attn)
    mix = merged.astype(x.dtype) @ w_out
    x = x + (gt1[:, None] * mix).astype(x.dtype)

    h2 = (_rmsnorm(x, norm2_g) * (1.0 + sc2[:, None]) + sh2[:, None]).astype(x.dtype)
    fg, fu = jnp.split(h2 @ w_ffn_in, 2, axis=-1)
    ff = (jax.nn.silu(fg.astype(jnp.float32)) * fu.astype(jnp.float32)).astype(x.dtype) @ w_ffn_out
    x = x + (gt2[:, None] * ff).astype(x.dtype)
    return x


def _encode(x, c, w_ada, b_ada, norm1_g, w_in, conv_w, conv_b, rg_wa, rg_ba, rg_wx, rg_bx, rg_lambda,
            w_br_rnn, w_br_attn, w_out, norm2_g, w_ffn_in, w_ffn_out, final_g):
    for l in range(DEPTH):
        x = _layer(x, c, w_ada[l], b_ada[l], norm1_g[l], w_in[l], conv_w[l], conv_b[l], rg_wa[l], rg_ba[l],
                   rg_wx[l], rg_bx[l], rg_lambda[l], w_br_rnn[l], w_br_attn[l], w_out[l], norm2_g[l],
                   w_ffn_in[l], w_ffn_out[l])
    return _rmsnorm(x, final_g)


def setup_inputs(seed: int = 0) -> dict:
    key = jax.random.key(seed)
    ks = jax.random.split(key, 24)

    def nrm(k, shape, s):
        return jax.random.normal(k, shape, jnp.float32) * s

    a0 = jax.random.uniform(ks[15], (DEPTH, 2, D_RNN), jnp.float32, minval=0.9, maxval=0.999)
    return {
        'x_prompt': nrm(ks[0], (BATCH, SEQ, D_MODEL), 1.0),
        'x_sample': nrm(ks[1], (DEC_BATCH, DEC_SEQ, D_MODEL), 1.0),
        'c_prompt': nrm(ks[2], (BATCH, D_MODEL), 1.0),
        'c_sample': nrm(ks[3], (DEC_BATCH, D_MODEL), 1.0),
        'w_ada': nrm(ks[4], (DEPTH, D_MODEL, N_MOD * D_MODEL), 0.5 * D_MODEL ** -0.5),
        'b_ada': nrm(ks[5], (DEPTH, N_MOD * D_MODEL), 0.01),
        'norm1_g': 1.0 + nrm(ks[6], (DEPTH, D_MODEL), 0.02),
        'w_in': nrm(ks[7], (DEPTH, D_MODEL, IN_COLS), D_MODEL ** -0.5),
        'conv_w': nrm(ks[8], (DEPTH, CONV_W, D_RNN), CONV_W ** -0.5),
        'conv_b': nrm(ks[9], (DEPTH, D_RNN), 0.01),
        'rg_wa': nrm(ks[10], (DEPTH, 2, RG_BLOCKS, RG_BW, RG_BW), RG_BW ** -0.5),
        'rg_ba': nrm(ks[11], (DEPTH, 2, RG_BLOCKS, RG_BW), 0.01),
        'rg_wx': nrm(ks[12], (DEPTH, 2, RG_BLOCKS, RG_BW, RG_BW), RG_BW ** -0.5),
        'rg_bx': nrm(ks[13], (DEPTH, 2, RG_BLOCKS, RG_BW), 0.01),
        'rg_lambda': jnp.log(a0) - jnp.log1p(-a0),
        'w_br_rnn': nrm(ks[16], (DEPTH, D_RNN, D_MODEL), D_RNN ** -0.5),
        'w_br_attn': nrm(ks[17], (DEPTH, ATT_OUT, D_MODEL), ATT_OUT ** -0.5),
        'w_out': nrm(ks[18], (DEPTH, D_MODEL, D_MODEL), D_MODEL ** -0.5),
        'norm2_g': 1.0 + nrm(ks[19], (DEPTH, D_MODEL), 0.02),
        'w_ffn_in': nrm(ks[20], (DEPTH, D_MODEL, 2 * D_FF), D_MODEL ** -0.5),
        'w_ffn_out': nrm(ks[21], (DEPTH, D_FF, D_MODEL), D_FF ** -0.5),
        'final_g': 1.0 + nrm(ks[22], (D_MODEL,), 0.02),
    }


def reference(x_prompt, x_sample, c_prompt, c_sample, w_ada, b_ada, norm1_g, w_in, conv_w, conv_b,
              rg_wa, rg_ba, rg_wx, rg_bx, rg_lambda, w_br_rnn, w_br_attn, w_out, norm2_g,
              w_ffn_in, w_ffn_out, final_g):
    y_prompt = _encode(x_prompt, c_prompt, w_ada, b_ada, norm1_g, w_in, conv_w, conv_b, rg_wa, rg_ba, rg_wx,
                       rg_bx, rg_lambda, w_br_rnn, w_br_attn, w_out, norm2_g, w_ffn_in, w_ffn_out, final_g)
    y_sample = _encode(x_sample, c_sample, w_ada, b_ada, norm1_g, w_in, conv_w, conv_b, rg_wa, rg_ba, rg_wx,
                       rg_bx, rg_lambda, w_br_rnn, w_br_attn, w_out, norm2_g, w_ffn_in, w_ffn_out, final_g)
    return (y_prompt, y_sample)
```

```cpp
#include <hip/hip_runtime.h>
#include <hip/hip_cooperative_groups.h>
#include <cstdio>
#include <cstdint>
namespace cg = cooperative_groups;

namespace pg8 {
#define PG8_LAS __attribute__((address_space(3)))
typedef unsigned short bf16_t;
typedef short bf16x8 __attribute__((ext_vector_type(8)));
typedef float f32x4 __attribute__((ext_vector_type(4)));
typedef unsigned u32x4 __attribute__((ext_vector_type(4)));
constexpr int BM = 256, BK = 64, HALF = 128, HTB = HALF * BK * 2  , STAGE_BYTES = 8 * HTB, NXCD = 8, WGM = 8;

__host__ __device__ __forceinline__ int lds_byte(int r, int c) { const int st = (r >> 4) * 2 + (c >> 5), rr = r & 15, cc = c & 31, ob = rr * 64 + cc * 2; return st * 1024 + (ob ^ (((ob >> 9) & 1) << 5)); }
__host__ __device__ __forceinline__ void stage_rc(int b, int& R, int& C) { const int st = b / 1024, sb = b % 1024, swz = sb ^ (((sb >> 9) & 1) << 5); R = (st >> 1) * 16 + swz / 64; C = (st & 1) * 32 + (swz % 64) / 2; }
__host__ __device__ __forceinline__ int perm32(int rho) { const int n = rho >> 4, i = rho & 15; return 8 * (i >> 2) + 4 * n + (i & 3); }

struct Unit { int pm, pn; };
struct Gemm { const bf16_t* A; const bf16_t* Bt; int M, N, K; };

struct StaticOrder {
    int nM, nN, nwg, G, c;
    __host__ __device__ void init(int M, int N, int G_, int c_) { nM = M / BM; nN = N / BM; nwg = nM * nN; G = G_; c = c_; }
    __host__ __device__ bool next(int i, Unit& u) const {
        const long L = (long)i * G + c; if (L >= nwg) return false;
        int wgid = (int)L; { const int q = nwg / NXCD, r = nwg % NXCD, xcd = wgid % NXCD, off = wgid / NXCD; wgid = (xcd < r ? xcd * (q + 1) : r * (q + 1) + (xcd - r) * q) + off; }
        const int nig = WGM * nN, gid = wgid / nig, fm = gid * WGM, gsz = (nM - fm) < WGM ? (nM - fm) : WGM;
        u.pm = fm + ((wgid % nig) % gsz); u.pn = (wgid % nig) / gsz; return true;
    }
    __device__ __forceinline__ void a_ready(const Unit&) const {}
    __device__ __forceinline__ void done(const Unit&) const {}
};


typedef float f32x2_t __attribute__((ext_vector_type(2))); typedef __bf16 bf16x2_t __attribute__((ext_vector_type(2)));
__device__ __forceinline__ unsigned pk2(float lo, float hi) { f32x2_t v = {lo, hi}; bf16x2_t b = __builtin_convertvector(v, bf16x2_t); return __builtin_bit_cast(unsigned, b); }
__device__ __forceinline__ float bflo(unsigned w) { return __uint_as_float(w << 16); }
__device__ __forceinline__ float bfhi(unsigned w) { return __uint_as_float(w & 0xffff0000u); }
__device__ __forceinline__ float fexp2(float x) { return __builtin_amdgcn_exp2f(x); }
__device__ __forceinline__ float frcp(float x) { return __builtin_amdgcn_rcpf(x); }
__device__ __forceinline__ float sigmoidf_(float x) { return frcp(1.0f + fexp2(-1.4426950408889634f * x)); }
__device__ __forceinline__ float gelu_tanh(float x) { const float u = x + 0.044715f * x * x * x; return x * frcp(1.0f + fexp2(-2.302208198f * u)); }
__device__ __forceinline__ void st16(bf16_t* p, const u32x4& v) { __builtin_nontemporal_store(v, (u32x4*)p); }
__device__ __forceinline__ u32x4 pack8(const f32x4& a, const f32x4& b) { u32x4 w; w.x = pk2(a[0], a[1]); w.y = pk2(a[2], a[3]); w.z = pk2(b[0], b[1]); w.w = pk2(b[2], b[3]); return w; }

constexpr float QSCALE = 0.125f * 1.4426950408889634f;

struct EpiInProj {
    static constexpr bool PERM = true, AFTER_DRAIN = false;
    bf16_t* XR; bf16_t* GR; bf16_t* Q; size_t qkv_stride; const float* rope; int S, lgS;
    __device__ __forceinline__ void operator()(const f32x4 (&acc)[2][2][4][2], const Unit& u, int wr, int wc, int fr, int fq) const {
        const int pn = u.pn, row0 = u.pm * BM + wr * 64 + fr;
        if (pn < 8) {
            bf16_t* base = XR; if (pn >= 4) base = GR; const int col0 = (pn & 3) * BM + wc * 32 + 8 * fq; const bool act = false;
#pragma unroll
            for (int ai = 0; ai < 2; ++ai)
#pragma unroll
                for (int m = 0; m < 4; ++m) { bf16_t* rowp = base + (size_t)(row0 + ai * HALF + m * 16) * 1024 + col0;
#pragma unroll
                    for (int bj = 0; bj < 2; ++bj) { f32x4 v0 = acc[ai][bj][m][0], v1 = acc[ai][bj][m][1];
                        if (act) {
#pragma unroll
                            for (int k = 0; k < 4; ++k) { v0[k] = gelu_tanh(v0[k]); v1[k] = gelu_tanh(v1[k]); } }
                        st16(rowp + bj * HALF, pack8(v0, v1)); } }
        } else {
            const int which = (pn - 8) / 6, pt = (pn - 8) % 6;
            const int g = pt >> 1, dsh = 2 * g, dil = 1 << dsh, L = S >> dsh;
            bf16_t* base = Q + (size_t)which * qkv_stride + (size_t)g * (262144u * 64u);
            const bool dorope = (which < 2) && ((wc & 1) == 0);
            const float osc = (which == 0) ? QSCALE : 1.0f;
#pragma unroll
            for (int ai = 0; ai < 2; ++ai)
#pragma unroll
                for (int m = 0; m < 4; ++m) {
                    const int tok = row0 + ai * HALF + m * 16, b = tok >> lgS, t = tok & (S - 1), mm = t >> dsh, rr = t & (dil - 1);
                    f32x4 cs = {1.f, 1.f, 1.f, 1.f}, sn = {0.f, 0.f, 0.f, 0.f};
                    if (dorope && fq < 2) { const f32x4* rp = (const f32x4*)(rope + (size_t)t * 16 + 8 * fq); const f32x4 a0 = rp[0], a1 = rp[1];
                        cs = (f32x4){a0[0], a0[2], a1[0], a1[2]}; sn = (f32x4){a0[1], a0[3], a1[1], a1[3]}; }
#pragma unroll
                    for (int bj = 0; bj < 2; ++bj) {
                        const int hh = (pt & 1) * 4 + bj * 2 + (wc >> 1), e0 = (wc & 1) * 32 + 8 * fq;
                        f32x4 v0 = acc[ai][bj][m][0], v1 = acc[ai][bj][m][1];
                        if (dorope && fq < 2) { const f32x4 x1 = v0, x2 = v1; v0 = x1 * cs - x2 * sn; v1 = x2 * cs + x1 * sn; }
                        v0 = v0 * osc; v1 = v1 * osc;
                        const size_t rho = ((size_t)((b * 8 + hh) * dil + rr)) * L + mm;
                        st16(base + rho * 64 + e0, pack8(v0, v1));
                    } }
        }
    }
};
struct EpiMg {
    static constexpr bool PERM = true, AFTER_DRAIN = false;
    bf16_t* MGR; bf16_t* MGA;
    __device__ __forceinline__ void operator()(const f32x4 (&acc)[2][2][4][2], const Unit& u, int wr, int wc, int fr, int fq) const {
        bf16_t* base = MGR; if (u.pn >= 4) base = MGA; const int col0 = (u.pn & 3) * BM + wc * 32 + 8 * fq, row0 = u.pm * BM + wr * 64 + fr;
#pragma unroll
        for (int ai = 0; ai < 2; ++ai)
#pragma unroll
            for (int m = 0; m < 4; ++m) { bf16_t* rowp = base + (size_t)(row0 + ai * HALF + m * 16) * 1024 + col0;
#pragma unroll
                for (int bj = 0; bj < 2; ++bj) { f32x4 v0 = acc[ai][bj][m][0], v1 = acc[ai][bj][m][1];
#pragma unroll
                    for (int k = 0; k < 4; ++k) { v0[k] = sigmoidf_(v0[k]); v1[k] = sigmoidf_(v1[k]); }
                    st16(rowp + bj * HALF, pack8(v0, v1)); } }
    }
};
template <bool FIRST> struct EpiBranch {
    static constexpr bool PERM = true, AFTER_DRAIN = false;
    bf16_t* O; const bf16_t* G;
    __device__ __forceinline__ void operator()(const f32x4 (&acc)[2][2][4][2], const Unit& u, int wr, int wc, int fr, int fq) const {
        const int col0 = u.pn * BM + wc * 32 + 8 * fq, row0 = u.pm * BM + wr * 64 + fr;
#pragma unroll
        for (int ai = 0; ai < 2; ++ai)
#pragma unroll
            for (int m = 0; m < 4; ++m) { const size_t off = (size_t)(row0 + ai * HALF + m * 16) * 1024 + col0;
#pragma unroll
                for (int bj = 0; bj < 2; ++bj) { const u32x4 gw = *(const u32x4*)(G + off + bj * HALF);
                    f32x4 g0 = {bflo(gw.x), bfhi(gw.x), bflo(gw.y), bfhi(gw.y)}, g1 = {bflo(gw.z), bfhi(gw.z), bflo(gw.w), bfhi(gw.w)};
                    f32x4 v0 = acc[ai][bj][m][0] * g0, v1 = acc[ai][bj][m][1] * g1;
                    if (!FIRST) { const u32x4 ow = *(const u32x4*)(O + off + bj * HALF);
                        v0 += (f32x4){bflo(ow.x), bfhi(ow.x), bflo(ow.y), bfhi(ow.y)}; v1 += (f32x4){bflo(ow.z), bfhi(ow.z), bflo(ow.w), bfhi(ow.w)}; }
                    *(u32x4*)(O + off + bj * HALF) = pack8(v0, v1); } }
    }
};
struct EpiResid {
    static constexpr bool PERM = true, AFTER_DRAIN = false;
    const float* base; float* out; const float* gate; int lgS; int gstride;
    __device__ __forceinline__ void operator()(const f32x4 (&acc)[2][2][4][2], const Unit& u, int wr, int wc, int fr, int fq) const {
        const int col0 = u.pn * BM + wc * 32 + 8 * fq, row0 = u.pm * BM + wr * 64 + fr; const int b = (u.pm * BM) >> lgS;
        f32x4 gv[2][2];
#pragma unroll
        for (int bj = 0; bj < 2; ++bj)
#pragma unroll
            for (int n = 0; n < 2; ++n) gv[bj][n] = *(const f32x4*)(gate + (size_t)b * gstride + col0 + bj * HALF + 4 * n);
#pragma unroll
        for (int ai = 0; ai < 2; ++ai)
#pragma unroll
            for (int m = 0; m < 4; ++m) { const size_t off = (size_t)(row0 + ai * HALF + m * 16) * 1024 + col0;
#pragma unroll
                for (int bj = 0; bj < 2; ++bj)
#pragma unroll
                    for (int n = 0; n < 2; ++n) { const f32x4 bs = *(const f32x4*)(base + off + bj * HALF + 4 * n);
                        __builtin_nontemporal_store(bs + gv[bj][n] * acc[ai][bj][m][n], (f32x4*)(out + off + bj * HALF + 4 * n)); } }
    }
};
struct EpiSwiglu {
    static constexpr bool PERM = true, AFTER_DRAIN = false;
    bf16_t* O; int ldc;
    __device__ __forceinline__ void operator()(const f32x4 (&acc)[2][2][4][2], const Unit& u, int wr, int wc, int fr, int fq) const {
        const int col0 = u.pn * HALF + wc * 32 + 8 * fq, row0 = u.pm * BM + wr * 64 + fr;
#pragma unroll
        for (int ai = 0; ai < 2; ++ai)
#pragma unroll
            for (int m = 0; m < 4; ++m) { f32x4 v0, v1;
#pragma unroll
                for (int k = 0; k < 4; ++k) { const float g0 = acc[ai][0][m][0][k], g1 = acc[ai][0][m][1][k];
                    v0[k] = g0 * sigmoidf_(g0) * acc[ai][1][m][0][k]; v1[k] = g1 * sigmoidf_(g1) * acc[ai][1][m][1][k]; }
                *(u32x4*)(O + (size_t)(row0 + ai * HALF + m * 16) * ldc + col0) = pack8(v0, v1); }
    }
};

struct EpiResidNorm {
    static constexpr bool PERM = true, AFTER_DRAIN = false;
    const float* base; bf16_t* out; bf16_t* xg; float* ss; const float* gate; const float* g2; const float* sc2; int lgS; int gstride;
    __device__ __forceinline__ void operator()(const f32x4 (&acc)[2][2][4][2], const Unit& u, int wr, int wc, int fr, int fq) const {
        const int col0 = u.pn * BM + wc * 32 + 8 * fq, row0 = u.pm * BM + wr * 64 + fr; const int b = (u.pm * BM) >> lgS;
        f32x4 gv[2][2], gs[2][2];
#pragma unroll
        for (int bj = 0; bj < 2; ++bj)
#pragma unroll
            for (int n = 0; n < 2; ++n) { const int c = col0 + bj * HALF + 4 * n; gv[bj][n] = *(const f32x4*)(gate + (size_t)b * gstride + c);
                gs[bj][n] = *(const f32x4*)(g2 + c) * (*(const f32x4*)(sc2 + (size_t)b * gstride + c) + 1.0f); }
#pragma unroll
        for (int ai = 0; ai < 2; ++ai)
#pragma unroll
            for (int m = 0; m < 4; ++m) { const int row = row0 + ai * HALF + m * 16; const size_t off = (size_t)row * 1024 + col0; float sq = 0.f;
#pragma unroll
                for (int bj = 0; bj < 2; ++bj) { f32x4 x0 = *(const f32x4*)(base + off + bj * HALF), x1 = *(const f32x4*)(base + off + bj * HALF + 4);
                    x0 += gv[bj][0] * acc[ai][bj][m][0]; x1 += gv[bj][1] * acc[ai][bj][m][1];
                    st16(out + off + bj * HALF, pack8(x0, x1));
                    sq += (x0[0] * x0[0] + x0[1] * x0[1]) + (x0[2] * x0[2] + x0[3] * x0[3]) + (x1[0] * x1[0] + x1[1] * x1[1]) + (x1[2] * x1[2] + x1[3] * x1[3]);
                    *(u32x4*)(xg + off + bj * HALF) = pack8(x0 * gs[bj][0], x1 * gs[bj][1]);     }
                sq += __shfl_xor(sq, 16); sq += __shfl_xor(sq, 32);
                if (fq == 0) atomicAdd(ss + row, sq); }
    }
};
struct EpiSwigluNorm {
    static constexpr bool PERM = true, AFTER_DRAIN = false;
    bf16_t* O; int ldc; const float* ss; const float* c2; int lgS; int c2stride;
    __device__ __forceinline__ void operator()(const f32x4 (&acc)[2][2][4][2], const Unit& u, int wr, int wc, int fr, int fq) const {
        const int col0 = u.pn * HALF + wc * 32 + 8 * fq, row0 = u.pm * BM + wr * 64 + fr, wrow0 = u.pn * BM + wc * 32 + 8 * fq; const int b = (u.pm * BM) >> lgS;
        const float* cb = c2 + (size_t)b * c2stride + wrow0;
        const f32x4 cg0 = *(const f32x4*)(cb), cg1 = *(const f32x4*)(cb + 4), cu0 = *(const f32x4*)(cb + HALF), cu1 = *(const f32x4*)(cb + HALF + 4);
#pragma unroll
        for (int ai = 0; ai < 2; ++ai)
#pragma unroll
            for (int m = 0; m < 4; ++m) { const int row = row0 + ai * HALF + m * 16; const float rstd = rsqrtf(ss[row] * (1.0f / 1024.0f) + 1e-6f);
                const f32x4 g0 = acc[ai][0][m][0] * rstd + cg0, g1 = acc[ai][0][m][1] * rstd + cg1, u0 = acc[ai][1][m][0] * rstd + cu0, u1 = acc[ai][1][m][1] * rstd + cu1;
                f32x4 v0, v1;
#pragma unroll
                for (int k = 0; k < 4; ++k) { v0[k] = g0[k] * sigmoidf_(g0[k]) * u0[k]; v1[k] = g1[k] * sigmoidf_(g1[k]) * u1[k]; }
                *(u32x4*)(O + (size_t)row * ldc + col0) = pack8(v0, v1);     }
    }
};

struct EpiResidBf {
    static constexpr bool PERM = true, AFTER_DRAIN = false;
    const bf16_t* base; bf16_t* out; const float* gate; int lgS; int gstride;
    __device__ __forceinline__ void operator()(const f32x4 (&acc)[2][2][4][2], const Unit& u, int wr, int wc, int fr, int fq) const {
        const int col0 = u.pn * BM + wc * 32 + 8 * fq, row0 = u.pm * BM + wr * 64 + fr; const int b = (u.pm * BM) >> lgS;
        f32x4 gv[2][2];
#pragma unroll
        for (int bj = 0; bj < 2; ++bj)
#pragma unroll
            for (int n = 0; n < 2; ++n) gv[bj][n] = *(const f32x4*)(gate + (size_t)b * gstride + col0 + bj * HALF + 4 * n);
#pragma unroll
        for (int ai = 0; ai < 2; ++ai)
#pragma unroll
            for (int m = 0; m < 4; ++m) { const size_t off = (size_t)(row0 + ai * HALF + m * 16) * 1024 + col0;
#pragma unroll
                for (int bj = 0; bj < 2; ++bj) { const u32x4 bw = *(const u32x4*)(base + off + bj * HALF);
                    const f32x4 x0 = (f32x4){bflo(bw.x), bfhi(bw.x), bflo(bw.y), bfhi(bw.y)} + gv[bj][0] * acc[ai][bj][m][0];
                    const f32x4 x1 = (f32x4){bflo(bw.z), bfhi(bw.z), bflo(bw.w), bfhi(bw.w)} + gv[bj][1] * acc[ai][bj][m][1];
                    st16(out + off + bj * HALF, pack8(x0, x1)); } }
    }
};
template <class Epi, class Sched, bool ALIGN_EPI = false, bool SP2 = false>
__device__ __forceinline__ void gemm_phase(PG8_LAS unsigned char* lds, const Gemm g, const Sched& S, const Epi& E) {
    int tid_ = threadIdx.x; asm volatile("" : "+v"(tid_));
    const int tid = tid_, wid = __builtin_amdgcn_readfirstlane(tid >> 6), lane = tid & 63, wr = wid >> 2, wc = wid & 3, fr = lane & 15, fq = lane >> 4;
    const int K = g.K, nt = K / BK;
    unsigned voffA[2], voffB[2];
#pragma unroll
    for (int i = 0; i < 2; ++i) { int R, C; stage_rc(tid * 16 + i * 8192, R, C); const int Rb = Epi::PERM ? ((R & ~31) + perm32(R & 31)) : R;
        voffA[i] = (unsigned)(R * K + C) * 2u; voffB[i] = (unsigned)(Rb * K + C) * 2u; }
    const size_t kstep = (size_t)(BK * 2);
    const size_t hstep = (size_t)HALF * K * 2;
    const size_t tstep = 2 * hstep;
    const unsigned ldsw = (unsigned)wid * 1024u;
    const int aoff = lds_byte(wr * 64 + fr, fq * 8), boff = lds_byte(wc * 32 + fr, fq * 8);
#define PG8_SA(b, h) (((b) * 2 + (h)) * HTB)
#define PG8_SB(b, h) ((4 + (b) * 2 + (h)) * HTB)
#define PG8_STAGE(bufoff, gbase, voff) do { _Pragma("unroll") for (int _i = 0; _i < 2; ++_i) \
        __builtin_amdgcn_global_load_lds((const unsigned*)((const char*)(gbase) + (voff)[_i]), (PG8_LAS unsigned*)(lds + (bufoff) + ldsw + _i * 8192), 16, 0, 0); } while (0)
#define PG8_LDA(dst, b, h) do { _Pragma("unroll") for (int m = 0; m < 4; ++m) _Pragma("unroll") for (int k = 0; k < 2; ++k) dst[m][k] = *(const PG8_LAS bf16x8*)(lds + PG8_SA(b, h) + aoff + m * 2048 + k * 1024); } while (0)
#define PG8_LDB(dst, b, h) do { _Pragma("unroll") for (int n = 0; n < 2; ++n) _Pragma("unroll") for (int k = 0; k < 2; ++k) dst[n][k] = *(const PG8_LAS bf16x8*)(lds + PG8_SB(b, h) + boff + n * 2048 + k * 1024); } while (0)
#define PG8_MMA(ai, bj, At, Bt) do { __builtin_amdgcn_s_setprio(1); _Pragma("unroll") for (int m = 0; m < 4; ++m) _Pragma("unroll") for (int n = 0; n < 2; ++n) _Pragma("unroll") for (int k = 0; k < 2; ++k) \
        acc[ai][bj][m][n] = __builtin_amdgcn_mfma_f32_16x16x32_bf16(Bt[n][k], At[m][k], acc[ai][bj][m][n], 0, 0, 0); __builtin_amdgcn_s_setprio(0); } while (0)
#define PG8_WAIT_V(n) asm volatile("s_waitcnt vmcnt(" #n ")" ::: "memory")
#define PG8_WAIT_L(n) asm volatile("s_waitcnt lgkmcnt(" #n ")" ::: "memory")
#define PG8_BAR __builtin_amdgcn_s_barrier()
#define PG8_SCHED __builtin_amdgcn_sched_barrier(0)
    Unit cur, nxt; int ui = 0;
    if (!S.next(0, cur)) return;
    f32x4 acc[2][2][4][2];
#pragma unroll
    for (int a = 0; a < 2; ++a)
#pragma unroll
        for (int b = 0; b < 2; ++b)
#pragma unroll
            for (int m = 0; m < 4; ++m)
#pragma unroll
                for (int n = 0; n < 2; ++n) acc[a][b][m][n] = (f32x4){0.f, 0.f, 0.f, 0.f};
    bf16x8 At[4][2], B0[2][2], B1[2][2];
    const char* cA = (const char*)g.A + (size_t)cur.pm * tstep; const char* cB = (const char*)g.Bt + (size_t)cur.pn * tstep;
    S.a_ready(cur);
    if constexpr (SP2) {
        PG8_STAGE(PG8_SB(0, 0), cB, voffB); PG8_STAGE(PG8_SB(0, 1), cB + hstep, voffB); PG8_STAGE(PG8_SA(0, 0), cA, voffA); PG8_STAGE(PG8_SA(0, 1), cA + hstep, voffA);
        if (wr == 1) PG8_BAR;
        PG8_WAIT_V(2); PG8_BAR;
        PG8_STAGE(PG8_SB(1, 0), cB + kstep, voffB); PG8_STAGE(PG8_SA(1, 0), cA + kstep, voffA); PG8_STAGE(PG8_SB(1, 1), cB + hstep + kstep, voffB);
        PG8_WAIT_V(6); PG8_BAR;
    } else {
        PG8_STAGE(PG8_SB(0, 0), cB, voffB); PG8_STAGE(PG8_SA(0, 0), cA, voffA); PG8_STAGE(PG8_SB(0, 1), cB + hstep, voffB); PG8_STAGE(PG8_SA(0, 1), cA + hstep, voffA);
        if (wr == 1) PG8_BAR;
        PG8_WAIT_V(4); PG8_BAR;
        PG8_STAGE(PG8_SB(1, 0), cB + kstep, voffB); PG8_STAGE(PG8_SA(1, 0), cA + kstep, voffA); PG8_STAGE(PG8_SB(1, 1), cB + hstep + kstep, voffB);
        PG8_WAIT_V(6); PG8_BAR;
    }
    for (;;) {
        const bool has_next = S.next(ui + 1, nxt);
        const char* nA = has_next ? (const char*)g.A + (size_t)nxt.pm * tstep : cA; const char* nB = has_next ? (const char*)g.Bt + (size_t)nxt.pn * tstep : cB;
        for (int t = 0; t < nt; t += 2) {
            const bool last = (t == nt - 2);
            const char* a1 = cA + (size_t)(t + 1) * kstep;
            const char* a2 = last ? nA : cA + (size_t)(t + 2) * kstep; const char* b2 = last ? nB : cB + (size_t)(t + 2) * kstep;
            const char* a3 = a2 + kstep; const char* b3 = b2 + kstep;
            if (last && has_next) S.a_ready(nxt);
            if constexpr (SP2) {
            PG8_LDB(B0, 0, 0); PG8_LDB(B1, 0, 1); PG8_SCHED; PG8_LDA(At, 0, 0); PG8_STAGE(PG8_SA(1, 1), a1 + hstep, voffA);
            PG8_WAIT_V(8); PG8_WAIT_L(0); PG8_BAR; PG8_MMA(0, 0, At, B0); PG8_MMA(0, 1, At, B1); PG8_BAR; PG8_SCHED;
            PG8_LDA(At, 0, 1); PG8_STAGE(PG8_SB(0, 0), b2, voffB); PG8_STAGE(PG8_SB(0, 1), b2 + hstep, voffB); PG8_STAGE(PG8_SA(0, 0), a2, voffA);
            PG8_WAIT_V(8); PG8_WAIT_L(0); PG8_BAR; PG8_MMA(1, 0, At, B0); PG8_MMA(1, 1, At, B1); PG8_BAR; PG8_SCHED;
            PG8_LDB(B0, 1, 0); PG8_LDB(B1, 1, 1); PG8_SCHED; PG8_LDA(At, 1, 0); PG8_STAGE(PG8_SA(0, 1), a2 + hstep, voffA);
            PG8_WAIT_V(8); PG8_WAIT_L(0); PG8_BAR; PG8_MMA(0, 0, At, B0); PG8_MMA(0, 1, At, B1); PG8_BAR; PG8_SCHED;
            PG8_LDA(At, 1, 1); PG8_STAGE(PG8_SB(1, 0), b3, voffB); PG8_STAGE(PG8_SB(1, 1), b3 + hstep, voffB); PG8_STAGE(PG8_SA(1, 0), a3, voffA);
            PG8_WAIT_V(8); PG8_WAIT_L(0); PG8_BAR; PG8_MMA(1, 0, At, B0); PG8_MMA(1, 1, At, B1); PG8_BAR; PG8_SCHED;
            } else {
            PG8_LDB(B0, 0, 0); PG8_SCHED; PG8_LDA(At, 0, 0); PG8_STAGE(PG8_SA(1, 1), a1 + hstep, voffA);
            PG8_WAIT_L(8); PG8_BAR; PG8_WAIT_L(0); PG8_MMA(0, 0, At, B0); PG8_BAR; PG8_SCHED;
            PG8_LDB(B1, 0, 1); PG8_STAGE(PG8_SB(0, 0), b2, voffB);
            PG8_BAR; PG8_WAIT_L(0); PG8_MMA(0, 1, At, B1); PG8_BAR;
            PG8_LDA(At, 0, 1); PG8_STAGE(PG8_SA(0, 0), a2, voffA);
            PG8_BAR; PG8_WAIT_L(0); PG8_MMA(1, 0, At, B0); PG8_BAR; PG8_SCHED;
            PG8_STAGE(PG8_SB(0, 1), b2 + hstep, voffB);
            PG8_WAIT_V(6); PG8_BAR; PG8_MMA(1, 1, At, B1); PG8_BAR;
            PG8_LDB(B0, 1, 0); PG8_SCHED; PG8_LDA(At, 1, 0); PG8_STAGE(PG8_SA(0, 1), a2 + hstep, voffA);
            PG8_WAIT_L(8); PG8_BAR; PG8_WAIT_L(0); PG8_MMA(0, 0, At, B0); PG8_BAR; PG8_SCHED;
            PG8_LDB(B1, 1, 1); PG8_STAGE(PG8_SB(1, 0), b3, voffB);
            PG8_BAR; PG8_WAIT_L(0); PG8_MMA(0, 1, At, B1); PG8_BAR;
            PG8_LDA(At, 1, 1); PG8_STAGE(PG8_SA(1, 0), a3, voffA);
            PG8_BAR; PG8_WAIT_L(0); PG8_MMA(1, 0, At, B0); PG8_BAR; PG8_SCHED;
            PG8_STAGE(PG8_SB(1, 1), b3 + hstep, voffB);
            PG8_WAIT_V(6); PG8_BAR; PG8_MMA(1, 1, At, B1); PG8_BAR;
            }
        }
        if constexpr (ALIGN_EPI) { if (wr == 0) PG8_BAR; }
        if constexpr (!Epi::AFTER_DRAIN) { E(acc, cur, wr, wc, fr, fq); S.done(cur); }
        if (!has_next) break;
#pragma unroll
        for (int a = 0; a < 2; ++a)
#pragma unroll
            for (int b = 0; b < 2; ++b)
#pragma unroll
                for (int m = 0; m < 4; ++m)
#pragma unroll
                    for (int n = 0; n < 2; ++n) acc[a][b][m][n] = (f32x4){0.f, 0.f, 0.f, 0.f};
        cur = nxt; cA = nA; cB = nB; ++ui;
        if constexpr (ALIGN_EPI) { if (wr == 1) PG8_BAR; }
    }
    PG8_WAIT_V(0);
    if constexpr (!ALIGN_EPI) { if (wr == 0) PG8_BAR; }
    PG8_BAR;
    if constexpr (Epi::AFTER_DRAIN) { E.fused(acc, cur, wr, wc, fr, fq, lds, wid, lane); S.done(cur); }
#undef PG8_SA
#undef PG8_SB
#undef PG8_STAGE
#undef PG8_LDA
#undef PG8_LDB
#undef PG8_MMA
#undef PG8_WAIT_V
#undef PG8_WAIT_L
#undef PG8_BAR
#undef PG8_SCHED
}
}

constexpr int DM = 1024, NHALF = 32768  , DFF = 2816, NMOD = 6144;
constexpr int NIN_A = 6656  , NIN_MG = 2048;
constexpr int NWAVES = 8, NTHREADS = 512;
constexpr float EPS = 1e-6f;
typedef unsigned short bf16_t;
typedef float f32x4 __attribute__((ext_vector_type(4)));
typedef float f32x16 __attribute__((ext_vector_type(16)));
typedef unsigned u32x4 __attribute__((ext_vector_type(4)));
typedef unsigned u32x2 __attribute__((ext_vector_type(2)));
typedef short bf16x8 __attribute__((ext_vector_type(8)));
typedef short s16x4 __attribute__((ext_vector_type(4)));
#define LAS __attribute__((address_space(3)))
using pg8::pk2; using pg8::bflo; using pg8::bfhi; using pg8::fexp2; using pg8::frcp; using pg8::sigmoidf_; using pg8::pack8;

constexpr size_t MiB = 1u << 20;
constexpr size_t WS_WIN = 0, WS_WFI = 17 * MiB, WS_WFO = 28 * MiB, WS_WBR = 34 * MiB, WS_WOUT = 36 * MiB, WS_WBA = 38 * MiB, WS_RGW = 39 * MiB;
constexpr size_t WS_MOD = 39 * MiB + 512 * 1024, WS_ROPE = 40 * MiB, WS_SP = 40 * MiB + 512 * 1024, WS_SUMM = 41 * MiB, WS_CARRY = 45 * MiB;
constexpr size_t WS_H1 = 48 * MiB;
constexpr size_t WS_XR = 112 * MiB;
constexpr size_t WS_Q = 176 * MiB;
constexpr size_t WS_PF = 176 * MiB, WS_PB = 304 * MiB, WS_ATT = 432 * MiB, WS_MGR = 112 * MiB, WS_MRG = 176 * MiB;
constexpr size_t WS_K = 272 * MiB;
constexpr size_t WS_V = 368 * MiB;
constexpr size_t WS_RNN = 48 * MiB;
constexpr size_t WS_BAR = 47 * MiB, BAR_BYTES = 16384;
constexpr size_t WS_SS = 47 * MiB + 65536  , WS_C2 = 47 * MiB + 262144  ;
constexpr size_t WS_AO2 = 464 * MiB, WS_LSE = 496 * MiB, WS_END = 499 * MiB;
constexpr size_t WS_HID = 240 * MiB;

constexpr int LDS_BYTES = 147456;

struct Params { const float* in[22]; float* out; unsigned char* ws; };

__device__ __forceinline__ float wave_sum(float v) {
#pragma unroll
    for (int o = 1; o < 64; o <<= 1) v += __shfl_xor(v, o);
    return v;
}

__device__ __forceinline__ void transpose_item(const float* W, int K, int N, bf16_t* WT, int k0, int n0, int dst_row0, LAS float* scr, int lane, float wscale = 1.0f, bool perm16 = false) {
    f32x4 t[8];
#pragma unroll
    for (int i = 0; i < 8; ++i) { const int kk = 8 * i + (lane >> 3); t[i] = *(const f32x4*)(W + (size_t)(k0 + kk) * N + n0 + 4 * (lane & 7)); }
#pragma unroll
    for (int i = 0; i < 8; ++i) { const int kk = 8 * i + (lane >> 3); LAS float* d = scr + kk * 33 + 4 * (lane & 7);
        d[0] = wscale * t[i].x; d[1] = wscale * t[i].y; d[2] = wscale * t[i].z; d[3] = wscale * t[i].w; }
    asm volatile("s_waitcnt lgkmcnt(0)" ::: "memory");
    const int c = lane & 7;
#pragma unroll
    for (int j = 0; j < 4; ++j) { const int n = (lane >> 3) + 8 * j; const LAS float* s = scr + (8 * c) * 33 + n;
        u32x4 o; o.x = pk2(s[0 * 33], s[1 * 33]); o.y = pk2(s[2 * 33], s[3 * 33]); o.z = pk2(s[4 * 33], s[5 * 33]); o.w = pk2(s[6 * 33], s[7 * 33]);
        const int nd = (perm16 && n < 16) ? ((n & 3) | ((n & 4) << 1) | ((n & 8) >> 1)) : n;
        *(u32x4*)(WT + (size_t)(dst_row0 + nd) * K + k0 + 8 * c) = o; }
    asm volatile("s_waitcnt lgkmcnt(0)" ::: "memory");
}
__device__ __forceinline__ void transpose_plain(const float* W, int K, int N, bf16_t* WT, int item, LAS float* scr, int lane) {
    const int nblk = N / 32, kb = item / nblk, nb = item % nblk; transpose_item(W, K, N, WT, 64 * kb, 32 * nb, 32 * nb, scr, lane);
}

#define BAR_LDS() asm volatile("s_waitcnt lgkmcnt(0)\n\ts_barrier" ::: "memory")
#define LAUNDER_TID() int tid_ = threadIdx.x; asm volatile("" : "+v"(tid_)); const int tid = tid_, lane = tid & 63, wave = __builtin_amdgcn_readfirstlane(tid >> 6); (void)lane; (void)wave
__device__ __forceinline__ void phase0(const Params& p, LAS unsigned char* lds) {
    LAUNDER_TID();
    unsigned char* ws = p.ws;
    const int G = gridDim.x;
    if (blockIdx.x < 96) {
        LAS float* sc = (LAS float*)lds;
        LAS float* red = (LAS float*)(lds + 49152);
        for (int i = tid; i < 12 * 1024; i += NTHREADS) { const int b = i >> 10, k = i & 1023; const float c = (b < 4) ? p.in[2][b * 1024 + k] : p.in[3][(b - 4) * 1024 + k]; sc[i] = c * sigmoidf_(c); }
        __syncthreads();
        const float* wada = p.in[4]; const int j = blockIdx.x * 64 + lane, kbeg = wave * 128;
        float acc[12];
#pragma unroll
        for (int b = 0; b < 12; ++b) acc[b] = 0.f;
#pragma unroll 16
        for (int kk = 0; kk < 128; ++kk) { const float w = wada[(size_t)(kbeg + kk) * NMOD + j];
#pragma unroll
            for (int b = 0; b < 12; ++b) acc[b] += sc[b * 1024 + kbeg + kk] * w; }
#pragma unroll
        for (int b = 0; b < 12; ++b) red[(wave * 12 + b) * 64 + lane] = acc[b];
        __syncthreads();
        float* mod = (float*)(ws + WS_MOD);
        for (int i = tid; i < 12 * 64; i += NTHREADS) { const int b = i >> 6, l = i & 63; float s = p.in[5][blockIdx.x * 64 + l];
#pragma unroll
            for (int w = 0; w < 8; ++w) s += red[(w * 12 + b) * 64 + l];
            mod[b * NMOD + blockIdx.x * 64 + l] = s; }
        __syncthreads();
    }
    const int gt = blockIdx.x * NTHREADS + tid, NGT = G * NTHREADS;
    { float* rope = (float*)(ws + WS_ROPE);
      for (int i = gt; i < 8192 * 8; i += NGT) { const int t = i >> 3, f = i & 7; const float inv = exp2f(-(float)f * 0.125f * 18.931568569324174f);
          const float ang = (float)t * inv; rope[2 * i] = cosf(ang); rope[2 * i + 1] = sinf(ang); }
      float* sp = (float*)(ws + WS_SP);
      for (int i = gt; i < 2048; i += NGT) { const float lam = p.in[14][i]; sp[i] = -8.0f * 1.4426950408889634f * log1pf(expf(-lam)); }
    }
    LAS float* scr = (LAS float*)(lds + wave * 16384);
    const int gw = blockIdx.x * NWAVES + wave, NGW = G * NWAVES;
    constexpr int I_IN = 16 * 272, I_BR = 16 * 32, I_BA = 8 * 32, I_OUT = 16 * 32, I_FI = 16 * 176, I_FO = 44 * 32, I_RG = 128;
    constexpr int NITEMS = I_IN + I_BR + I_BA + I_OUT + I_FI + I_FO + I_RG;
    const bool split = (G > 96) && (96 * NWAVES * 2 < NITEMS);
    const int modw = 96 * NWAVES, first = split ? ((blockIdx.x < 96) ? gw : 2 * modw + (gw - modw)) : gw;
    const int step = split ? ((blockIdx.x < 96) ? modw : (NGW - modw)) : NGW, last = (split && blockIdx.x < 96) ? 2 * modw : NITEMS;
    for (int it = first; it < last; it += step) {
        int r = it;
        if (r < I_IN) { const int kb = r / 272, nb = r % 272, n0 = 32 * nb; const bool rot = (n0 >= 2048) && (n0 < 5120) && ((n0 & 63) == 0);
            transpose_item(p.in[7], 1024, 8704, (bf16_t*)(ws + WS_WIN), 64 * kb, n0, n0, scr, lane, 1.0f, rot); continue; } r -= I_IN;
        if (r < I_BR) { transpose_plain(p.in[15], 1024, 1024, (bf16_t*)(ws + WS_WBR), r, scr, lane); continue; } r -= I_BR;
        if (r < I_BA) { transpose_plain(p.in[16], 512, 1024, (bf16_t*)(ws + WS_WBA), r, scr, lane); continue; } r -= I_BA;
        if (r < I_OUT) { transpose_plain(p.in[17], 1024, 1024, (bf16_t*)(ws + WS_WOUT), r, scr, lane); continue; } r -= I_OUT;
        if (r < I_FI) { const int kb = r / 176, nb = r % 176, n0 = 32 * nb; const int jj = (n0 < DFF) ? n0 : n0 - DFF;
            const int dst = 256 * (jj >> 7) + (jj & 127) + ((n0 < DFF) ? 0 : 128);
            transpose_item(p.in[19], 1024, 2 * DFF, (bf16_t*)(ws + WS_WFI), 64 * kb, n0, dst, scr, lane); continue; } r -= I_FI;
        if (r < I_FO) { transpose_plain(p.in[20], DFF, 1024, (bf16_t*)(ws + WS_WFO), r, scr, lane); continue; } r -= I_FO;
        { const int mat = r >> 1, nb = r & 1, gate = mat >> 5, dn = mat & 31;
          const float* src = (gate ? p.in[12] : p.in[10]) + (size_t)dn * 4096; const int dir = dn >> 4, n = dn & 15;
          bf16_t* dst = (bf16_t*)(ws + WS_RGW) + (size_t)(((dir * 2 + gate) * 16 + n)) * 4096;
          transpose_item(src, 64, 64, dst, 0, 32 * nb, 32 * nb, scr, lane, -1.4426950408889634f); }
    }
}

__device__ __forceinline__ void rownorm_mod(const float* src, bf16_t* dst, const float* g, const float* mod, int sh_off, int sc_off, int lgS, int bbase, float* ss_zero) {
    LAUNDER_TID();
    const int gw = blockIdx.x * NWAVES + wave, NGW = gridDim.x * NWAVES;
    for (int row0 = 2 * gw; row0 < NHALF; row0 += 2 * NGW) {
        f32x4 v[2][4]; float s[2];
#pragma unroll
        for (int q = 0; q < 2; ++q) { const f32x4* xr = (const f32x4*)(src + (size_t)(row0 + q) * DM) + lane;
#pragma unroll
            for (int j = 0; j < 4; ++j) v[q][j] = xr[64 * j]; }
#pragma unroll
        for (int q = 0; q < 2; ++q) { float t = 0.f;
#pragma unroll
            for (int j = 0; j < 4; ++j) t += (v[q][j].x * v[q][j].x + v[q][j].y * v[q][j].y) + (v[q][j].z * v[q][j].z + v[q][j].w * v[q][j].w);
            s[q] = t; }
#pragma unroll
        for (int o = 1; o < 64; o <<= 1) { s[0] += __shfl_xor(s[0], o); s[1] += __shfl_xor(s[1], o); }
        const float* mb = mod + (size_t)(bbase + (row0 >> lgS)) * NMOD;
        if (lane < 2) ss_zero[row0 + lane] = 0.f;
#pragma unroll
        for (int q = 0; q < 2; ++q) { const float rstd = rsqrtf(s[q] * (1.f / DM) + EPS);
            u32x2* o8 = (u32x2*)(dst + (size_t)(row0 + q) * DM) + lane;
#pragma unroll
            for (int j = 0; j < 4; ++j) { const int idx = 4 * lane + 256 * j;
                const f32x4 gg = *(const f32x4*)(g + idx), sc = *(const f32x4*)(mb + sc_off + idx), sh = *(const f32x4*)(mb + sh_off + idx);
                const f32x4 o = v[q][j] * rstd * gg * (sc + 1.0f) + sh;
                u32x2 w; w.x = pk2(o.x, o.y); w.y = pk2(o.z, o.w); o8[64 * j] = w; } }
    }
}
__device__ __forceinline__ void rownorm_final(const bf16_t* src, float* dst, const float* g) {
    LAUNDER_TID();
    const int gw = blockIdx.x * NWAVES + wave, NGW = gridDim.x * NWAVES;
    const f32x4 g0 = *(const f32x4*)(g + 8 * lane), g1 = *(const f32x4*)(g + 8 * lane + 4), g2 = *(const f32x4*)(g + 512 + 8 * lane), g3 = *(const f32x4*)(g + 512 + 8 * lane + 4);
    for (int row0 = 2 * gw; row0 < NHALF; row0 += 2 * NGW) {
        u32x4 w[2][2]; float s[2];
#pragma unroll
        for (int q = 0; q < 2; ++q) { const u32x4* xr = (const u32x4*)(src + (size_t)(row0 + q) * DM) + lane; w[q][0] = xr[0]; w[q][1] = xr[64]; }
        f32x4 v[2][4];
#pragma unroll
        for (int q = 0; q < 2; ++q) {
#pragma unroll
            for (int j = 0; j < 2; ++j) { v[q][2 * j] = (f32x4){bflo(w[q][j].x), bfhi(w[q][j].x), bflo(w[q][j].y), bfhi(w[q][j].y)}; v[q][2 * j + 1] = (f32x4){bflo(w[q][j].z), bfhi(w[q][j].z), bflo(w[q][j].w), bfhi(w[q][j].w)}; }
            float t = 0.f;
#pragma unroll
            for (int j = 0; j < 4; ++j) t += (v[q][j].x * v[q][j].x + v[q][j].y * v[q][j].y) + (v[q][j].z * v[q][j].z + v[q][j].w * v[q][j].w);
            s[q] = t; }
#pragma unroll
        for (int o = 1; o < 64; o <<= 1) { s[0] += __shfl_xor(s[0], o); s[1] += __shfl_xor(s[1], o); }
#pragma unroll
        for (int q = 0; q < 2; ++q) { const float rstd = rsqrtf(s[q] * (1.f / DM) + EPS);
            f32x4* orow = (f32x4*)(dst + (size_t)(row0 + q) * DM) + 2 * lane;
            __builtin_nontemporal_store(v[q][0] * rstd * g0, orow); __builtin_nontemporal_store(v[q][1] * rstd * g1, orow + 1);
            __builtin_nontemporal_store(v[q][2] * rstd * g2, orow + 128); __builtin_nontemporal_store(v[q][3] * rstd * g3, orow + 129); }
    }
}

__device__ __forceinline__ void compute_c2(const Params& p) {
    LAUNDER_TID();
    const bf16_t* WT = (const bf16_t*)(p.ws + WS_WFI); const float* mod = (const float*)(p.ws + WS_MOD); float* C2 = (float*)(p.ws + WS_C2);
    const int gw = blockIdx.x * NWAVES + wave, NGW = gridDim.x * NWAVES;
    for (int n = gw; n < 2 * DFF; n += NGW) {
        const u32x4 w0 = *(const u32x4*)(WT + (size_t)n * DM + 16 * lane), w1 = *(const u32x4*)(WT + (size_t)n * DM + 16 * lane + 8);
        const float wf[16] = {bflo(w0.x), bfhi(w0.x), bflo(w0.y), bfhi(w0.y), bflo(w0.z), bfhi(w0.z), bflo(w0.w), bfhi(w0.w), bflo(w1.x), bfhi(w1.x), bflo(w1.y), bfhi(w1.y), bflo(w1.z), bfhi(w1.z), bflo(w1.w), bfhi(w1.w)};
        float mine = 0.f;
#pragma unroll
        for (int b = 0; b < 12; ++b) { const f32x4* sh = (const f32x4*)(mod + (size_t)b * NMOD + 3072 + 16 * lane); float s = 0.f;
#pragma unroll
            for (int q = 0; q < 4; ++q) { const f32x4 t = sh[q]; s += (t.x * wf[4 * q] + t.y * wf[4 * q + 1]) + (t.z * wf[4 * q + 2] + t.w * wf[4 * q + 3]); }
            s = wave_sum(s); if (lane == b) mine = s; }
        if (lane < 12) C2[(size_t)lane * (2 * DFF) + n] = mine;
    }
}

#define MFMA32(a, b, c) __builtin_amdgcn_mfma_f32_32x32x16_bf16((a), (b), (c), 0, 0, 0)
__device__ __forceinline__ int crow(int reg, int h) { return (reg & 3) + 8 * (reg >> 2) + 4 * h; }
typedef short v4i16_t __attribute__((ext_vector_type(4)));
__device__ __forceinline__ s16x4 vtr(const LAS unsigned char* p) { return __builtin_bit_cast(s16x4, __builtin_amdgcn_ds_read_tr16_b64_v4i16((LAS v4i16_t*)p)); }
constexpr int AK_PITCH = 144, AK_BYTES = 384 * AK_PITCH, AV_HALF = 384 * 64, ATT_WSF = AK_BYTES + 2 * AV_HALF;

__device__ __forceinline__ void attn_load(const bf16_t* Kg, const bf16_t* Vg, int v, int L, u32x4 (&kr)[6], u32x4 (&vr)[6], int tid) {
    const int rho0 = 256 * v, m0 = rho0 & (L - 1);
#pragma unroll
    for (int it = 0; it < 6; ++it) { const int idx = it * NTHREADS + tid, kk = idx >> 3, c = idx & 7, m = m0 - 64 + kk; const bool ok = (m >= 0) && (m < L);
        const size_t off = ok ? ((size_t)(rho0 - 64 + kk) * 64 + c * 8) : 0;
        u32x4 kv = *(const u32x4*)(Kg + off), vv = *(const u32x4*)(Vg + off);
        if (!ok) { kv = (u32x4){0u, 0u, 0u, 0u}; vv = kv; }
        kr[it] = kv; vr[it] = vv; }
}
__device__ __forceinline__ void attn_loadq(const bf16_t* Qg, int v, bf16x8 (&q)[4], int lane, int wave) {
    const bf16_t* qp = Qg + (size_t)(256 * v + 32 * wave + (lane & 31)) * 64 + 8 * (lane >> 5);
#pragma unroll
    for (int d0 = 0; d0 < 4; ++d0) q[d0] = *(const bf16x8*)(qp + 16 * d0);
}
__device__ __forceinline__ void attn_unit(LAS unsigned char* lds, bf16_t* AOg, float* LSEg, int v, int L, int dsh, int S,
                                          u32x4 (&kr)[6], u32x4 (&vr)[6], bf16x8 (&qnext)[4], int tid, int lane, int wave, const bf16_t* Qf, const bf16_t* Kf, const bf16_t* Vf, int un) {
    const int r = lane & 31, h = lane >> 5;
    const int rho0 = 256 * v, m0 = rho0 & (L - 1), sigma = rho0 / L;
    LAS unsigned char* Ks = lds; LAS unsigned char* Vs = lds + AK_BYTES; LAS float* wsf = (LAS float*)(lds + ATT_WSF) + wave * 32;
#pragma unroll
    for (int it = 0; it < 6; ++it) { const int idx = it * NTHREADS + tid, kk = idx >> 3, c = idx & 7;
        *(LAS u32x4*)(Ks + kk * AK_PITCH + c * 16) = kr[it]; *(LAS u32x4*)(Vs + (c >> 2) * AV_HALF + kk * 64 + (c & 3) * 16) = vr[it]; }
    bf16x8 qr[4];
#pragma unroll
    for (int d0 = 0; d0 < 4; ++d0) qr[d0] = qnext[d0];
    BAR_LDS();
    if (un < 3072) { const int gn = un >> 10; attn_load(Kf + (size_t)gn * 262144 * 64, Vf + (size_t)gn * 262144 * 64, un & 1023, S >> (2 * gn), kr, vr, tid);
        attn_loadq(Qf + (size_t)gn * 262144 * 64, un & 1023, qnext, lane, wave); }
    f32x16 p[5]; float mx = -INFINITY;
#pragma unroll
    for (int j = 0; j < 5; ++j) {
        const int mlo = m0 + 32 * wave - 64 + 32 * j; const bool tv = (mlo >= 0) && (mlo + 32 <= L);
        f32x16 a = {};
        const LAS unsigned char* kp = Ks + (32 * wave + 32 * j + r) * AK_PITCH + h * 16;
#pragma unroll
        for (int d0 = 0; d0 < 4; ++d0) { const bf16x8 kf = *(const LAS bf16x8*)(kp + d0 * 32); a = MFMA32(kf, qr[d0], a); }
#pragma unroll
        for (int i = 0; i < 16; ++i) { const int key = crow(i, h); bool ok = tv; if (j == 0) ok = ok && (key >= r); if (j == 4) ok = ok && (key <= r);
            const float s = ok ? a[i] : -INFINITY; p[j][i] = s; mx = fmaxf(mx, s); }
    }
    mx = fmaxf(mx, __shfl_xor(mx, 32));
    float l = 0.f;
#pragma unroll
    for (int j = 0; j < 5; ++j)
#pragma unroll
        for (int i = 0; i < 16; ++i) { const float e = fexp2(p[j][i] - mx); p[j][i] = e; l += e; }
    l += __shfl_xor(l, 32);
    f32x16 o0 = {}, o1 = {};
    const LAS unsigned char* vb = Vs + ((lane >> 4) & 1) * 32 + (lane & 3) * 8 + (4 * h + ((lane & 15) >> 2)) * 64 + (32 * wave) * 64;
#pragma unroll
    for (int j = 0; j < 5; ++j)
#pragma unroll
        for (int s = 0; s < 2; ++s) {
            u32x4 pw; pw.x = pk2(p[j][8 * s + 0], p[j][8 * s + 1]); pw.y = pk2(p[j][8 * s + 2], p[j][8 * s + 3]); pw.z = pk2(p[j][8 * s + 4], p[j][8 * s + 5]); pw.w = pk2(p[j][8 * s + 6], p[j][8 * s + 7]);
            const bf16x8 pa = __builtin_bit_cast(bf16x8, pw);
            const LAS unsigned char* vp = vb + (32 * j + 16 * s) * 64;
            const s16x4 lo0 = vtr(vp), hi0 = vtr(vp + 512), lo1 = vtr(vp + AV_HALF), hi1 = vtr(vp + AV_HALF + 512);
            const bf16x8 vf0 = __builtin_shufflevector(lo0, hi0, 0, 1, 2, 3, 4, 5, 6, 7), vf1 = __builtin_shufflevector(lo1, hi1, 0, 1, 2, 3, 4, 5, 6, 7);
            o0 = MFMA32(pa, vf0, o0); o1 = MFMA32(pa, vf1, o1);
        }
#pragma unroll
    for (int it = 0; it < 6; ++it) asm volatile("" : "+v"(kr[it]), "+v"(vr[it]));
#pragma unroll
    for (int d0 = 0; d0 < 4; ++d0) asm volatile("" : "+v"(qnext[d0]));
    const float rl = frcp(l);
    if (h == 0) wsf[r] = rl;
    const int dil = 1 << dsh, rr = sigma & (dil - 1), bh = sigma >> dsh, hh = bh & 7, b = bh >> 3;
    if (h == 0) { const int mq = m0 + 32 * wave + r; const int tok = b * S + (mq << dsh) + rr; LSEg[(size_t)tok * 8 + hh] = mx + __log2f(l); }
#pragma unroll
    for (int i = 0; i < 16; ++i) { const int q = crow(i, h); const float sc = wsf[q]; const int mq = m0 + 32 * wave + q; const int tok = b * S + (mq << dsh) + rr;
        bf16_t* op = AOg + (size_t)tok * 512 + hh * 64 + r;
        __builtin_nontemporal_store((bf16_t)(pk2(o0[i] * sc, 0.f) & 0xffffu), op); __builtin_nontemporal_store((bf16_t)(pk2(o1[i] * sc, 0.f) & 0xffffu), op + 32); }
    BAR_LDS();
}


__device__ __forceinline__ void attn_phase(LAS unsigned char* lds, const bf16_t* Qf, const bf16_t* Kf, const bf16_t* Vf, bf16_t* AO0, bf16_t* AO1, bf16_t* AO2, float* LSE, int S) {
    LAUNDER_TID();
    const int G = gridDim.x; constexpr size_t GS = (size_t)262144 * 64;
    u32x4 kr[6], vr[6]; bf16x8 qn[4];
    int u = blockIdx.x;
    if (u < 3072) { const int g = u >> 10; attn_load(Kf + g * GS, Vf + g * GS, u & 1023, S >> (2 * g), kr, vr, tid); attn_loadq(Qf + g * GS, u & 1023, qn, lane, wave); }
    else {
#pragma unroll
        for (int d0 = 0; d0 < 4; ++d0) qn[d0] = (bf16x8){0, 0, 0, 0, 0, 0, 0, 0}; }
    for (; u < 3072; u += G) { const int g = u >> 10, v = u & 1023, dsh = 2 * g;
        bf16_t* AOg = (g == 0) ? AO0 : (g == 1 ? AO1 : AO2);
        attn_unit(lds, AOg, LSE + (size_t)g * NHALF * 8, v, S >> dsh, dsh, S, kr, vr, qn, tid, lane, wave, Qf, Kf, Vf, u + G); }
}

__device__ __forceinline__ void attn_merge(const bf16_t* AO0, const bf16_t* AO1, const bf16_t* AO2, const float* LSE, bf16_t* ATT) {
    LAUNDER_TID();
    const int gt = blockIdx.x * NTHREADS + tid, NGT = gridDim.x * NTHREADS;
    for (int idx0 = gt; idx0 < NHALF * 64; idx0 += 2 * NGT) {
        u32x4 a[2], b[2], c[2]; float l0[2], l1[2], l2[2]; size_t off[2];
#pragma unroll
        for (int q = 0; q < 2; ++q) { int idx = idx0 + q * NGT; if (idx >= NHALF * 64) idx = NHALF * 64 - 1; const int tok = idx >> 6, c8 = idx & 63, hh = c8 >> 3;
            l0[q] = LSE[(size_t)tok * 8 + hh]; l1[q] = LSE[(size_t)NHALF * 8 + (size_t)tok * 8 + hh]; l2[q] = LSE[(size_t)2 * NHALF * 8 + (size_t)tok * 8 + hh];
            off[q] = (size_t)tok * 512 + c8 * 8; a[q] = *(const u32x4*)(AO0 + off[q]); b[q] = *(const u32x4*)(AO1 + off[q]); c[q] = *(const u32x4*)(AO2 + off[q]); }
#pragma unroll
        for (int q = 0; q < 2; ++q) { if (idx0 + q * NGT >= NHALF * 64) continue;
            const float mx = fmaxf(l0[q], fmaxf(l1[q], l2[q])); float w0 = fexp2(l0[q] - mx), w1 = fexp2(l1[q] - mx), w2 = fexp2(l2[q] - mx); const float inv = frcp(w0 + w1 + w2); w0 *= inv; w1 *= inv; w2 *= inv;
            const u32x4 A = a[q], B = b[q], C = c[q]; u32x4 o;
            o.x = pk2(w0 * bflo(A.x) + w1 * bflo(B.x) + w2 * bflo(C.x), w0 * bfhi(A.x) + w1 * bfhi(B.x) + w2 * bfhi(C.x));
            o.y = pk2(w0 * bflo(A.y) + w1 * bflo(B.y) + w2 * bflo(C.y), w0 * bfhi(A.y) + w1 * bfhi(B.y) + w2 * bfhi(C.y));
            o.z = pk2(w0 * bflo(A.z) + w1 * bflo(B.z) + w2 * bflo(C.z), w0 * bfhi(A.z) + w1 * bfhi(B.z) + w2 * bfhi(C.z));
            o.w = pk2(w0 * bflo(A.w) + w1 * bflo(B.w) + w2 * bflo(C.w), w0 * bfhi(A.w) + w1 * bfhi(B.w) + w2 * bfhi(C.w));
            *(u32x4*)(ATT + off[q]) = o; }
    }
}

constexpr int XC_PITCH = 136  ;
__device__ __forceinline__ float fsqrt_(float x) { return __builtin_amdgcn_sqrtf(x); }

template <int DIR>
__device__ __forceinline__ void rnn_wave(const LAS bf16_t* XC, unsigned* PD  , int loff  ,
                                         const bf16x8 (&wr_)[4], const bf16x8 (&wi_)[4], float bR, float bI, float c1, float& Aout, float& Bout, int colbase, int r, int h) {
    float c = 0.f, Pc = 1.f;
#pragma unroll 1
    for (int it = 0; it < 4; ++it) {
        const int tt = DIR ? 3 - it : it;
        f32x16 aR, aI;
#pragma unroll
        for (int i = 0; i < 16; ++i) { aR[i] = bR; aI[i] = bI; }
#pragma unroll
        for (int ks = 0; ks < 4; ++ks) { const bf16x8 xa = *(const LAS bf16x8*)(XC + (32 * tt + r) * XC_PITCH + (colbase & 64) + 16 * ks + 8 * h);
            aR = MFMA32(xa, wr_[ks], aR); aI = MFMA32(xa, wi_[ks], aI); }
        float a[16], u[16];
#pragma unroll
        for (int i = 0; i < 16; ++i) { const float xv = bflo((unsigned)XC[(32 * tt + crow(i, h)) * XC_PITCH + colbase + r]);
            const float rg = frcp(1.0f + fexp2(aR[i])), ig = frcp(1.0f + fexp2(aI[i])); const float av = fexp2(rg * c1);
            a[i] = av; u[i] = fsqrt_(1.0f - av * av) * (ig * xv); }
        float Ag[4], Bg[4], pA[4], pB[4];
#pragma unroll
        for (int g = 0; g < 4; ++g) {
            if (DIR == 0) { float A = a[4 * g], B = u[4 * g];
#pragma unroll
                for (int i = 1; i < 4; ++i) { B = B * a[4 * g + i] + u[4 * g + i]; A *= a[4 * g + i]; }
                Ag[g] = A; Bg[g] = B; }
            else { float A = a[4 * g + 3], B = u[4 * g + 3];
#pragma unroll
                for (int i = 2; i >= 0; --i) { B = B * a[4 * g + i] + u[4 * g + i]; A *= a[4 * g + i]; }
                Ag[g] = A; Bg[g] = B; }
            pA[g] = __shfl_xor(Ag[g], 32); pB[g] = __shfl_xor(Bg[g], 32);
        }
        float cown[4], pown[4];
#pragma unroll
        for (int kk = 0; kk < 8; ++kk) { const int k = DIR ? 7 - kk : kk; const int g = k >> 1, hh = k & 1; const bool mine = (hh == h);
            const float A = mine ? Ag[g] : pA[g], B = mine ? Bg[g] : pB[g];
            if (mine) { cown[g] = c; pown[g] = Pc; }
            c = A * c + B; Pc *= A; }
#pragma unroll
        for (int g = 0; g < 4; ++g) { float hp = cown[g], pp = pown[g];
#pragma unroll
            for (int ii = 0; ii < 4; ++ii) { const int i = DIR ? 3 - ii : ii; hp = a[4 * g + i] * hp + u[4 * g + i]; pp *= a[4 * g + i];
                unsigned* rowp = PD + (size_t)(32 * tt + crow(4 * g + i, 0)) * DM;
                __builtin_nontemporal_store(pk2(hp, pp), rowp + loff); } }
    }
    Aout = Pc; Bout = c;
}

__device__ __forceinline__ void rnn_fetch(const bf16_t* XR, int item, int S, int tid, u32x4 (&xw)[7]) {
    const int ci = item >> 3, np = item & 7, tok0 = ci * 128, t0 = tok0 & (S - 1), c8 = tid & 15, tg = tid >> 4, ch = 128 * np + 8 * c8;
#pragma unroll
    for (int j = 0; j < 7; ++j) { const int tk = 4 * tg + j - 2, ts = t0 + tk; const bool ok = (ts >= 0) && (ts < S); const int rowc = ok ? (tok0 + tk) : tok0;
        xw[j] = *(const u32x4*)(XR + (size_t)rowc * DM + ch); if (!ok) xw[j] = (u32x4){0u, 0u, 0u, 0u}; }
}
constexpr int RNN_CW_OFF = 40960;
__device__ __forceinline__ void rnn_pass1(const Params& p, LAS unsigned char* lds, const bf16_t* XR, unsigned* PF, unsigned* PB, int S) {
    LAUNDER_TID();
    unsigned char* ws = p.ws;
    LAS bf16_t* XC = (LAS bf16_t*)lds; LAS float* CW = (LAS float*)(lds + RNN_CW_OFF);
    const float* convw = p.in[8]; const float* convb = p.in[9];
    const int r = lane & 31, h = lane >> 5, rb = wave >> 2, chalf = (wave >> 1) & 1, dir = wave & 1, colbase = 64 * rb + 32 * chalf;
    float* SUMM = (float*)(ws + WS_SUMM);
    const int NITEM = 256 * 8, G = gridDim.x;
    int item = blockIdx.x, np_cur = -1;
    u32x4 xw[7];
    bf16x8 wr_[4], wi_[4]; float bR = 0.f, bI = 0.f, c1 = 0.f;
#pragma unroll
    for (int ks = 0; ks < 4; ++ks) { wr_[ks] = (bf16x8){0, 0, 0, 0, 0, 0, 0, 0}; wi_[ks] = wr_[ks]; }
    if (item < NITEM) rnn_fetch(XR, item, S, tid, xw);
    for (; item < NITEM; item += G) {
        const int ci = item >> 3, np = item & 7, tok0 = ci * 128;
        const int n = 2 * np + rb, d = 32 * chalf + r, chg = 64 * n + d;
        if (np != np_cur) {
            np_cur = np;
            for (int i = tid; i < 640; i += NTHREADS) CW[i] = (i < 512) ? convw[(i >> 7) * DM + 128 * np + (i & 127)] : convb[128 * np + (i - 512)];
            const bf16_t* gr = (const bf16_t*)(ws + WS_RGW) + (size_t)(((dir * 2 + 0) * 16 + n) * 64 + d) * 64 + 8 * h; const bf16_t* gi = gr + (size_t)16 * 4096;
#pragma unroll
            for (int ks = 0; ks < 4; ++ks) { wr_[ks] = *(const bf16x8*)(gr + 16 * ks); wi_[ks] = *(const bf16x8*)(gi + 16 * ks); }
            bR = -1.4426950408889634f * p.in[11][dir * 1024 + chg]; bI = -1.4426950408889634f * p.in[13][dir * 1024 + chg]; c1 = ((const float*)(ws + WS_SP))[dir * 1024 + chg];
            __syncthreads();
        }
        { const int c8 = tid & 15, tg = tid >> 4;
          float xf[7][8];
#pragma unroll
          for (int j = 0; j < 7; ++j) { xf[j][0] = bflo(xw[j].x); xf[j][1] = bfhi(xw[j].x); xf[j][2] = bflo(xw[j].y); xf[j][3] = bfhi(xw[j].y); xf[j][4] = bflo(xw[j].z); xf[j][5] = bfhi(xw[j].z); xf[j][6] = bflo(xw[j].w); xf[j][7] = bfhi(xw[j].w); }
          float o[4][8];
          { const f32x4 b0 = *(const LAS f32x4*)(CW + 512 + 8 * c8), b1 = *(const LAS f32x4*)(CW + 512 + 8 * c8 + 4);
#pragma unroll
            for (int q = 0; q < 4; ++q) { o[q][0] = b0.x; o[q][1] = b0.y; o[q][2] = b0.z; o[q][3] = b0.w; o[q][4] = b1.x; o[q][5] = b1.y; o[q][6] = b1.z; o[q][7] = b1.w; } }
#pragma unroll
          for (int k = 0; k < 4; ++k) { const f32x4 w0 = *(const LAS f32x4*)(CW + k * 128 + 8 * c8), w1 = *(const LAS f32x4*)(CW + k * 128 + 8 * c8 + 4);
              const float wk[8] = {w0.x, w0.y, w0.z, w0.w, w1.x, w1.y, w1.z, w1.w};
#pragma unroll
              for (int q = 0; q < 4; ++q)
#pragma unroll
                  for (int e = 0; e < 8; ++e) o[q][e] += xf[q + k][e] * wk[e]; }
#pragma unroll
          for (int q = 0; q < 4; ++q) { u32x4 w; w.x = pk2(o[q][0], o[q][1]); w.y = pk2(o[q][2], o[q][3]); w.z = pk2(o[q][4], o[q][5]); w.w = pk2(o[q][6], o[q][7]);
              *(LAS u32x4*)(XC + (4 * tg + q) * XC_PITCH + 8 * c8) = w; } }
        BAR_LDS();
        if (item + G < NITEM) rnn_fetch(XR, item + G, S, tid, xw);
        float Ao, Bo;
        if (dir == 0) rnn_wave<0>(XC, PF + (size_t)tok0 * DM, chg + 4 * h * DM, wr_, wi_, bR, bI, c1, Ao, Bo, colbase, r, h);
        else          rnn_wave<1>(XC, PB + (size_t)tok0 * DM, chg + 4 * h * DM, wr_, wi_, bR, bI, c1, Ao, Bo, colbase, r, h);
        if (h == 0) { float* sp = SUMM + (((size_t)ci * 2 + dir) * 1024 + chg) * 2; sp[0] = Ao; sp[1] = Bo; }
        BAR_LDS();
    }
}

__device__ __forceinline__ void rnn_pass2(const Params& p, const unsigned* PF, const unsigned* PB, const bf16_t* GRG, bf16_t* RNN) {
    LAUNDER_TID();
    const float* CARRY = (const float*)(p.ws + WS_CARRY);
    const int gt = blockIdx.x * NTHREADS + tid, NGT = gridDim.x * NTHREADS;
    for (int idx = gt; idx < NHALF * 128; idx += NGT) { const int tok = idx >> 7, ch = (idx & 127) * 8, ci = tok >> 7;
        const size_t off = (size_t)tok * DM + ch;
        const u32x4 f0 = *(const u32x4*)(PF + off), f1 = *(const u32x4*)(PF + off + 4), b0 = *(const u32x4*)(PB + off), b1 = *(const u32x4*)(PB + off + 4);
        const f32x4 cf0 = *(const f32x4*)(CARRY + ((size_t)ci * 2 + 0) * 1024 + ch), cf1 = *(const f32x4*)(CARRY + ((size_t)ci * 2 + 0) * 1024 + ch + 4);
        const f32x4 cb0 = *(const f32x4*)(CARRY + ((size_t)ci * 2 + 1) * 1024 + ch), cb1 = *(const f32x4*)(CARRY + ((size_t)ci * 2 + 1) * 1024 + ch + 4);
        const u32x4 gw = *(const u32x4*)(GRG + off);
        float v[8];
        v[0] = bflo(f0.x) + bfhi(f0.x) * cf0.x + bflo(b0.x) + bfhi(b0.x) * cb0.x; v[1] = bflo(f0.y) + bfhi(f0.y) * cf0.y + bflo(b0.y) + bfhi(b0.y) * cb0.y;
        v[2] = bflo(f0.z) + bfhi(f0.z) * cf0.z + bflo(b0.z) + bfhi(b0.z) * cb0.z; v[3] = bflo(f0.w) + bfhi(f0.w) * cf0.w + bflo(b0.w) + bfhi(b0.w) * cb0.w;
        v[4] = bflo(f1.x) + bfhi(f1.x) * cf1.x + bflo(b1.x) + bfhi(b1.x) * cb1.x; v[5] = bflo(f1.y) + bfhi(f1.y) * cf1.y + bflo(b1.y) + bfhi(b1.y) * cb1.y;
        v[6] = bflo(f1.z) + bfhi(f1.z) * cf1.z + bflo(b1.z) + bfhi(b1.z) * cb1.z; v[7] = bflo(f1.w) + bfhi(f1.w) * cf1.w + bflo(b1.w) + bfhi(b1.w) * cb1.w;
        using pg8::gelu_tanh;
        u32x4 o; o.x = pk2(v[0] * gelu_tanh(bflo(gw.x)), v[1] * gelu_tanh(bfhi(gw.x))); o.y = pk2(v[2] * gelu_tanh(bflo(gw.y)), v[3] * gelu_tanh(bfhi(gw.y))); o.z = pk2(v[4] * gelu_tanh(bflo(gw.z)), v[5] * gelu_tanh(bfhi(gw.z))); o.w = pk2(v[6] * gelu_tanh(bflo(gw.w)), v[7] * gelu_tanh(bfhi(gw.w)));
        *(u32x4*)(RNN + off) = o; }
}

template <int NC>
__device__ __forceinline__ void carry_scan_t(const float* SUMM, float* CARRY, int nseq, int tid) {
    const int gt = blockIdx.x * NTHREADS + tid, NGT = gridDim.x * NTHREADS;
    for (int idx = gt; idx < nseq * 2048; idx += NGT) { const int seq = idx >> 11, dir = (idx >> 10) & 1, ch = idx & 1023;
        const size_t o0 = ((size_t)(seq * NC + (dir ? NC - 1 : 0)) * 2 + dir) * 1024 + ch; const long step = dir ? -2048 : 2048;
        float2 ab[NC];
#pragma unroll
        for (int k = 0; k < NC; ++k) ab[k] = *(const float2*)(SUMM + (o0 + k * step) * 2);
        float c = 0.f;
#pragma unroll
        for (int k = 0; k < NC; ++k) { CARRY[o0 + k * step] = c; c = ab[k].x * c + ab[k].y; }
    }
}
__device__ __forceinline__ void carry_scan(const Params& p, int S, int nseq) {
    LAUNDER_TID();
    const float* SUMM = (const float*)(p.ws + WS_SUMM); float* CARRY = (float*)(p.ws + WS_CARRY);
    if (S == 8192) carry_scan_t<64>(SUMM, CARRY, nseq, tid); else carry_scan_t<32>(SUMM, CARRY, nseq, tid);
}

#define XB_TMO      128
#define XB_XCNT(j)  (256  + 64 * (j))
#define XB_XSUB(j)  (1280 + 64 * (j))
#define XB_XGEN(j)  (2304 + 64 * (j))
#define XB_TOP      3328
#define XB_TOPGEN   3392
#define XCD_BAR_WORDS 3456
#define XB_SPIN_CAP (1u << 18)

__device__ __forceinline__ unsigned xb_ld(unsigned* p)              { return __hip_atomic_load(p, __ATOMIC_RELAXED, __HIP_MEMORY_SCOPE_AGENT); }
__device__ __forceinline__ unsigned xb_add(unsigned* p, unsigned v) { return __hip_atomic_fetch_add(p, v, __ATOMIC_RELAXED, __HIP_MEMORY_SCOPE_AGENT); }
__device__ __forceinline__ unsigned xb_xcc_id() { return (unsigned)__builtin_amdgcn_s_getreg((3 << 11) | 20) & 0xFu; }
#define XB_SPIN(cond, bar) do { unsigned _sp = 0; while (cond) { __builtin_amdgcn_s_sleep(1); \
    if ((++_sp & 255u) == 0u) { if (xb_ld(&(bar)[XB_TMO])) break; if (_sp > XB_SPIN_CAP) { atomicAdd(&(bar)[XB_TMO], 1u); break; } } } } while (0)

struct XcdBarrier {
    unsigned* bar; unsigned x;
    volatile LAS unsigned* st;
};

__device__ __forceinline__ XcdBarrier xcd_barrier_post(unsigned* bar, volatile LAS unsigned* st) {
    XcdBarrier b; b.bar = bar; b.x = xb_xcc_id(); b.st = st;
    if (threadIdx.x == 0) (void)xb_add(&bar[XB_XCNT(b.x)], 1u);
    return b;
}
__device__ __forceinline__ void xcd_barrier_complete(unsigned* bar, unsigned x, unsigned& nloc, unsigned& nx) {
    const unsigned G = gridDim.x * gridDim.y * gridDim.z;
    unsigned sum, cnt, mine, sp = 0u;
    for (;;) {
        sum = 0u; cnt = 0u; mine = 0u;
#pragma unroll
        for (unsigned j = 0; j < 16; ++j) { const unsigned c = xb_ld(&bar[XB_XCNT(j)]); sum += c; cnt += (c > 0u) ? 1u : 0u; mine = (j == x) ? c : mine; }
        if (sum == G) break;
        __builtin_amdgcn_s_sleep(1);
        if ((++sp & 255u) == 0u) { if (xb_ld(&bar[XB_TMO])) break; if (sp > XB_SPIN_CAP) { atomicAdd(&bar[XB_TMO], 1u); break; } }
    }
    nloc = mine > 0u ? mine : 1u; nx = cnt > 0u ? cnt : 1u;
}

__device__ __forceinline__ void xcd_barrier(const XcdBarrier& b) {
    asm volatile("s_waitcnt vmcnt(0)" ::: "memory");
    __syncthreads();
    if (threadIdx.x == 0) {
        unsigned* bar = b.bar; const unsigned bx_ = xb_xcc_id();
        __builtin_amdgcn_s_waitcnt(0);
        unsigned nloc = b.st[0], nx = b.st[1];
        if (nloc == 0u) { xcd_barrier_complete(bar, bx_, nloc, nx); b.st[0] = nloc; b.st[1] = nx; }
        const unsigned old = xb_add(&bar[XB_XSUB(bx_)], 1u);
        const unsigned gen = old / nloc;
        if (old + 1u == (gen + 1u) * nloc) {
            __builtin_amdgcn_fence(__ATOMIC_RELEASE, "agent");
            asm volatile("s_waitcnt vmcnt(0)" ::: "memory");
            const unsigned og = xb_add(&bar[XB_TOP], 1u);
            const unsigned tg = og / nx;
            if (og + 1u == (tg + 1u) * nx) xb_add(&bar[XB_TOPGEN], 1u);
            else XB_SPIN(xb_ld(&bar[XB_TOPGEN]) == tg, bar);
            __builtin_amdgcn_fence(__ATOMIC_ACQUIRE, "agent");
            xb_add(&bar[XB_XGEN(bx_)], 1u);
            asm volatile("s_waitcnt vmcnt(0)" ::: "memory");
        } else {
            XB_SPIN(xb_ld(&bar[XB_XGEN(bx_)]) == gen, bar);
            __builtin_amdgcn_fence(__ATOMIC_ACQUIRE, "agent");
            asm volatile("s_waitcnt vmcnt(0)" ::: "memory");
        }
    }
    __syncthreads();
}

#define GAS __attribute__((address_space(1)))
#define PHASE_PTRS() GAS unsigned char* wsg_ = (GAS unsigned char*)ws_; asm volatile("" : "+s"(wsg_)); unsigned char* ws = (unsigned char*)wsg_; GAS float* dog_ = (GAS float*)dout_; asm volatile("" : "+s"(dog_)); float* dout = (float*)dog_;     const float* mod = (const float*)(ws + WS_MOD); \
bf16_t* H1 = (bf16_t*)(ws + WS_H1); bf16_t* XR = (bf16_t*)(ws + WS_XR); bf16_t* GRG = (bf16_t*)dout; \
        bf16_t* Qf = (bf16_t*)(ws + WS_Q); bf16_t* Kf = (bf16_t*)(ws + WS_K); bf16_t* Vf = (bf16_t*)(ws + WS_V); \
        bf16_t* AO0 = (bf16_t*)((unsigned char*)dout + 64 * MiB); bf16_t* AO1 = (bf16_t*)((unsigned char*)dout + 96 * MiB); bf16_t* AO2 = (bf16_t*)(ws + WS_AO2); \
        float* LSE = (float*)(ws + WS_LSE); \
        unsigned* PF = (unsigned*)(ws + WS_PF); unsigned* PB = (unsigned*)(ws + WS_PB); \
        bf16_t* ATT = (bf16_t*)(ws + WS_ATT); bf16_t* MGR = (bf16_t*)(ws + WS_MGR); bf16_t* MGA = (bf16_t*)((unsigned char*)dout + 64 * MiB); bf16_t* RNN = (bf16_t*)(ws + WS_RNN); \
        bf16_t* MRG = (bf16_t*)(ws + WS_MRG); bf16_t* H2 = (bf16_t*)(ws + WS_H1); bf16_t* HID = (bf16_t*)(ws + WS_HID); \
        bf16_t* X1B = (bf16_t*)(ws + WS_XR); bf16_t* X2B = (bf16_t*)(ws + WS_MRG);
__global__ void __launch_bounds__(NTHREADS, 2) fwd_megakernel(Params p) {
    extern __shared__ __attribute__((aligned(16))) unsigned char lds_raw[];
    LAS unsigned char* lds = (LAS unsigned char*)lds_raw;
    cg::grid_group grid = cg::this_grid();
    volatile LAS unsigned* MISC = (volatile LAS unsigned*)(lds + 131072);
    if (threadIdx.x < 64) MISC[threadIdx.x] = 0u;
    __syncthreads();
    const XcdBarrier xbar = xcd_barrier_post((unsigned*)(p.ws + WS_BAR), MISC + 8);
    unsigned char* ws_ = p.ws;
    const int G = gridDim.x, bx = blockIdx.x;

#ifndef PHMASK
#define PHMASK 0xffff
#endif
#define EN(k) ((PHMASK >> (k)) & 1)
#ifndef REP_GEMM
#define REP_GEMM 1
#endif
#ifndef REP_OTHER
#define REP_OTHER 1
#endif
#define RG for (int rep_ = 0; rep_ < REP_GEMM; ++rep_)
#define RO for (int rep_ = 0; rep_ < REP_OTHER; ++rep_)
#ifndef REP_ATT
#define REP_ATT 1
#endif
#ifndef REP_RNN
#define REP_RNN 1
#endif
#define RA for (int rep_ = 0; rep_ < REP_ATT; ++rep_)
#define RR for (int rep_ = 0; rep_ < REP_RNN; ++rep_)
    if (EN(0)) phase0(p, lds);
    if (p.ws == nullptr) grid.sync();
    xcd_barrier(xbar);

    for (int half = 0; half < 2; ++half) {
        const int S = half ? 4096 : 8192, lgS = half ? 12 : 13, nseq = half ? 8 : 4, bbase = half ? 4 : 0;
        const float* xin = p.in[half];
        float* dout_ = p.out + (size_t)half * NHALF * DM;
        { PHASE_PTRS();
        RO if (EN(1)) rownorm_mod(xin, H1, p.in[6], mod, 0, 1024, lgS, bbase, (float*)(ws + WS_SS));
        if (half == 0) compute_c2(p);
        }
        xcd_barrier(xbar);
        { PHASE_PTRS();
        RG if (EN(2)) { pg8::Gemm g{H1, (const bf16_t*)(ws + WS_WIN), NHALF, NIN_A, DM}; pg8::StaticOrder So; So.init(NHALF, NIN_A, G, bx);
          pg8::EpiInProj E{XR, GRG, Qf, (size_t)(WS_K - WS_Q) / 2, (const float*)(ws + WS_ROPE), S, lgS};
          static_assert(WS_V - WS_K == WS_K - WS_Q, "q/k/v equally spaced");
          pg8::gemm_phase<pg8::EpiInProj, pg8::StaticOrder, true, true>(lds, g, So, E); }
        }
        xcd_barrier(xbar);
        { PHASE_PTRS();
        RA if (EN(3)) attn_phase(lds, Qf, Kf, Vf, AO0, AO1, AO2, LSE, S);
        }
        xcd_barrier(xbar);
        { PHASE_PTRS();
        RO if (EN(5)) attn_merge(AO0, AO1, AO2, LSE, ATT);
        RR if (EN(4)) rnn_pass1(p, lds, XR, PF, PB, S);
        }
        xcd_barrier(xbar);
        { PHASE_PTRS();
        RG if (EN(6)) { pg8::Gemm g{H1, (const bf16_t*)(ws + WS_WIN) + (size_t)NIN_A * DM, NHALF, NIN_MG, DM}; pg8::StaticOrder So; So.init(NHALF, NIN_MG, G, bx);
          pg8::EpiMg E{MGR, MGA};
          pg8::gemm_phase<pg8::EpiMg, pg8::StaticOrder, true, true>(lds, g, So, E); }
        RO if (EN(5)) carry_scan(p, S, nseq);
        }
        xcd_barrier(xbar);
        { PHASE_PTRS();
        RO if (EN(7)) rnn_pass2(p, PF, PB, GRG, RNN);
        }
        xcd_barrier(xbar);
        { PHASE_PTRS();
        RG if (EN(8)) { pg8::Gemm g{RNN, (const bf16_t*)(ws + WS_WBR), NHALF, DM, DM}; pg8::StaticOrder So; So.init(NHALF, DM, G, bx);
          pg8::EpiBranch<true> E{MRG, MGR};
          pg8::gemm_phase<pg8::EpiBranch<true>, pg8::StaticOrder, true, true>(lds, g, So, E); }
        if (EN(9)) { pg8::Gemm g{ATT, (const bf16_t*)(ws + WS_WBA), NHALF, DM, 512}; pg8::StaticOrder So; So.init(NHALF, DM, G, bx);
          pg8::EpiBranch<false> E{MRG, MGA};
          pg8::gemm_phase<pg8::EpiBranch<false>, pg8::StaticOrder, true, true>(lds, g, So, E); }
        }
        xcd_barrier(xbar);
        { PHASE_PTRS();
        if (EN(10)) { pg8::Gemm g{MRG, (const bf16_t*)(ws + WS_WOUT), NHALF, DM, DM}; pg8::StaticOrder So; So.init(NHALF, DM, G, bx);
          pg8::EpiResidNorm E{xin, X1B, H2, (float*)(ws + WS_SS), mod + (size_t)bbase * NMOD + 2048, p.in[18], mod + (size_t)bbase * NMOD + 4096, lgS, NMOD};
          pg8::gemm_phase<pg8::EpiResidNorm, pg8::StaticOrder, true, true>(lds, g, So, E); }
        }
        xcd_barrier(xbar);
        { PHASE_PTRS();
        RG if (EN(12)) { pg8::Gemm g{H2, (const bf16_t*)(ws + WS_WFI), NHALF, 2 * DFF, DM}; pg8::StaticOrder So; So.init(NHALF, 2 * DFF, G, bx);
          pg8::EpiSwigluNorm E{HID, DFF, (const float*)(ws + WS_SS), (const float*)(ws + WS_C2) + (size_t)bbase * (2 * DFF), lgS, 2 * DFF};
          pg8::gemm_phase<pg8::EpiSwigluNorm, pg8::StaticOrder, true, true>(lds, g, So, E); }
        }
        xcd_barrier(xbar);
        { PHASE_PTRS();
        if (EN(13)) { pg8::Gemm g{HID, (const bf16_t*)(ws + WS_WFO), NHALF, DM, DFF}; pg8::StaticOrder So; So.init(NHALF, DM, G, bx);
          pg8::EpiResidBf E{X1B, X2B, mod + (size_t)bbase * NMOD + 5120, lgS, NMOD};
          pg8::gemm_phase<pg8::EpiResidBf, pg8::StaticOrder, true, true>(lds, g, So, E); }
        }
        xcd_barrier(xbar);
        { PHASE_PTRS();
        if (EN(14)) rownorm_final(X2B, dout, p.in[21]);
        }
    }
}

extern "C" void kernel_launch(void* const* d_in, const int* in_sizes, int n_in, void* d_out, int out_size, void* d_ws, size_t ws_size, hipStream_t stream) {
    static int grid = 0;
    if (grid == 0) {
        if (n_in != 22 || out_size != 2 * NHALF * DM || ws_size < WS_END) { fprintf(stderr, "kernel_launch: unexpected shapes (n_in %d out %d ws %zu)\n", n_in, out_size, ws_size); grid = -1; return; }
        int dev = 0, cus = 0, per_cu = 0;
        (void)hipGetDevice(&dev); (void)hipDeviceGetAttribute(&cus, hipDeviceAttributeMultiprocessorCount, dev);
        if (hipFuncSetAttribute((const void*)fwd_megakernel, hipFuncAttributeMaxDynamicSharedMemorySize, LDS_BYTES) != hipSuccess) { fprintf(stderr, "kernel_launch: hipFuncSetAttribute failed\n"); grid = -1; return; }
        if (hipOccupancyMaxActiveBlocksPerMultiprocessor(&per_cu, (const void*)fwd_megakernel, NTHREADS, LDS_BYTES) != hipSuccess || per_cu < 1) per_cu = 1;
        (void)hipGetLastError();
        grid = cus * per_cu;
    }
    if (grid < 0) return;
    Params prm{};
    for (int i = 0; i < 22; ++i) prm.in[i] = (const float*)d_in[i];
    prm.out = (float*)d_out; prm.ws = (unsigned char*)d_ws;
    if (hipMemsetAsync((char*)d_ws + WS_BAR, 0, BAR_BYTES, stream) != hipSuccess) { fprintf(stderr, "kernel_launch: memset of the barrier words failed\n"); return; }
    void* args[] = {&prm};
    hipError_t e = hipLaunchCooperativeKernel((const void*)fwd_megakernel, dim3(grid), dim3(NTHREADS), args, LDS_BYTES, stream);
    if (e != hipSuccess) fprintf(stderr, "cooperative launch failed: %s (grid %d)\n", hipGetErrorString(e), grid);
}
```

```cpp
#include <hip/hip_runtime.h>
#include <hip/hip_cooperative_groups.h>
#include <cstdio>
#include <cstdint>
namespace cg = cooperative_groups;

namespace pg8 {
#define PG8_LAS __attribute__((address_space(3)))
typedef unsigned short bf16_t;
typedef short bf16x8 __attribute__((ext_vector_type(8)));
typedef float f32x4 __attribute__((ext_vector_type(4)));
typedef unsigned u32x4 __attribute__((ext_vector_type(4)));
constexpr int BM = 256, BK = 64, HALF = 128, HTB = HALF * BK * 2  , STAGE_BYTES = 8 * HTB, NXCD = 8, WGM = 8;

__host__ __device__ __forceinline__ int lds_byte(int r, int c) { const int st = (r >> 4) * 2 + (c >> 5), rr = r & 15, cc = c & 31, ob = rr * 64 + cc * 2; return st * 1024 + (ob ^ (((ob >> 9) & 1) << 5)); }
__host__ __device__ __forceinline__ void stage_rc(int b, int& R, int& C) { const int st = b / 1024, sb = b % 1024, swz = sb ^ (((sb >> 9) & 1) << 5); R = (st >> 1) * 16 + swz / 64; C = (st & 1) * 32 + (swz % 64) / 2; }
__host__ __device__ __forceinline__ int perm32(int rho) { const int n = rho >> 4, i = rho & 15; return 8 * (i >> 2) + 4 * n + (i & 3); }

struct Unit { int pm, pn; };
struct Gemm { const bf16_t* A; const bf16_t* Bt; int M, N, K; };

struct StaticOrder {
    int nM, nN, nwg, G, c;
    __host__ __device__ void init(int M, int N, int G_, int c_) { nM = M / BM; nN = N / BM; nwg = nM * nN; G = G_; c = c_; }
    __host__ __device__ bool next(int i, Unit& u) const {
        const long L = (long)i * G + c; if (L >= nwg) return false;
        int wgid = (int)L; { const int q = nwg / NXCD, r = nwg % NXCD, xcd = wgid % NXCD, off = wgid / NXCD; wgid = (xcd < r ? xcd * (q + 1) : r * (q + 1) + (xcd - r) * q) + off; }
        const int nig = WGM * nN, gid = wgid / nig, fm = gid * WGM, gsz = (nM - fm) < WGM ? (nM - fm) : WGM;
        u.pm = fm + ((wgid % nig) % gsz); u.pn = (wgid % nig) / gsz; return true;
    }
    __device__ __forceinline__ void a_ready(const Unit&) const {}
    __device__ __forceinline__ void done(const Unit&) const {}
};


typedef float f32x2_t __attribute__((ext_vector_type(2))); typedef __bf16 bf16x2_t __attribute__((ext_vector_type(2)));
__device__ __forceinline__ unsigned pk2(float lo, float hi) { f32x2_t v = {lo, hi}; bf16x2_t b = __builtin_convertvector(v, bf16x2_t); return __builtin_bit_cast(unsigned, b); }
__device__ __forceinline__ float bflo(unsigned w) { return __uint_as_float(w << 16); }
__device__ __forceinline__ float bfhi(unsigned w) { return __uint_as_float(w & 0xffff0000u); }
__device__ __forceinline__ float fexp2(float x) { return __builtin_amdgcn_exp2f(x); }
__device__ __forceinline__ float frcp(float x) { return __builtin_amdgcn_rcpf(x); }
__device__ __forceinline__ float sigmoidf_(float x) { return frcp(1.0f + fexp2(-1.4426950408889634f * x)); }
__device__ __forceinline__ float gelu_tanh(float x) { const float u = x + 0.044715f * x * x * x; return x * frcp(1.0f + fexp2(-2.302208198f * u)); }
__device__ __forceinline__ void st16(bf16_t* p, const u32x4& v) { __builtin_nontemporal_store(v, (u32x4*)p); }
__device__ __forceinline__ u32x4 pack8(const f32x4& a, const f32x4& b) { u32x4 w; w.x = pk2(a[0], a[1]); w.y = pk2(a[2], a[3]); w.z = pk2(b[0], b[1]); w.w = pk2(b[2], b[3]); return w; }

constexpr float QSCALE = 0.125f * 1.4426950408889634f;

struct EpiInProj {
    static constexpr bool PERM = true, AFTER_DRAIN = false;
    bf16_t* XR; bf16_t* GR; bf16_t* Q; size_t qkv_stride; const float* rope; int S, lgS;
    __device__ __forceinline__ void operator()(const f32x4 (&acc)[2][2][4][2], const Unit& u, int wr, int wc, int fr, int fq) const {
        const int pn = u.pn, row0 = u.pm * BM + wr * 64 + fr;
        if (pn < 8) {
            bf16_t* base = XR; if (pn >= 4) base = GR; const int col0 = (pn & 3) * BM + wc * 32 + 8 * fq; const bool act = false;
#pragma unroll
            for (int ai = 0; ai < 2; ++ai)
#pragma unroll
                for (int m = 0; m < 4; ++m) { bf16_t* rowp = base + (size_t)(row0 + ai * HALF + m * 16) * 1024 + col0;
#pragma unroll
                    for (int bj = 0; bj < 2; ++bj) { f32x4 v0 = acc[ai][bj][m][0], v1 = acc[ai][bj][m][1];
                        if (act) {
#pragma unroll
                            for (int k = 0; k < 4; ++k) { v0[k] = gelu_tanh(v0[k]); v1[k] = gelu_tanh(v1[k]); } }
                        st16(rowp + bj * HALF, pack8(v0, v1)); } }
        } else {
            const int which = (pn - 8) / 6, pt = (pn - 8) % 6;
            const int g = pt >> 1, dsh = 2 * g, dil = 1 << dsh, L = S >> dsh;
            bf16_t* base = Q + (size_t)which * qkv_stride + (size_t)g * (262144u * 64u);
            const bool dorope = (which < 2) && ((wc & 1) == 0);
            const float osc = (which == 0) ? QSCALE : 1.0f;
#pragma unroll
            for (int ai = 0; ai < 2; ++ai)
#pragma unroll
                for (int m = 0; m < 4; ++m) {
                    const int tok = row0 + ai * HALF + m * 16, b = tok >> lgS, t = tok & (S - 1), mm = t >> dsh, rr = t & (dil - 1);
                    f32x4 cs = {1.f, 1.f, 1.f, 1.f}, sn = {0.f, 0.f, 0.f, 0.f};
                    if (dorope && fq < 2) { const f32x4* rp = (const f32x4*)(rope + (size_t)t * 16 + 8 * fq); const f32x4 a0 = rp[0], a1 = rp[1];
                        cs = (f32x4){a0[0], a0[2], a1[0], a1[2]}; sn = (f32x4){a0[1], a0[3], a1[1], a1[3]}; }
#pragma unroll
                    for (int bj = 0; bj < 2; ++bj) {
                        const int hh = (pt & 1) * 4 + bj * 2 + (wc >> 1), e0 = (wc & 1) * 32 + 8 * fq;
                        f32x4 v0 = acc[ai][bj][m][0], v1 = acc[ai][bj][m][1];
                        if (dorope && fq < 2) { const f32x4 x1 = v0, x2 = v1; v0 = x1 * cs - x2 * sn; v1 = x2 * cs + x1 * sn; }
                        v0 = v0 * osc; v1 = v1 * osc;
                        const size_t rho = ((size_t)((b * 8 + hh) * dil + rr)) * L + mm;
                        st16(base + rho * 64 + e0, pack8(v0, v1));
                    } }
        }
    }
};
struct EpiMg {
    static constexpr bool PERM = true, AFTER_DRAIN = false;
    bf16_t* MGR; bf16_t* MGA;
    __device__ __forceinline__ void operator()(const f32x4 (&acc)[2][2][4][2], const Unit& u, int wr, int wc, int fr, int fq) const {
        bf16_t* base = MGR; if (u.pn >= 4) base = MGA; const int col0 = (u.pn & 3) * BM + wc * 32 + 8 * fq, row0 = u.pm * BM + wr * 64 + fr;
#pragma unroll
        for (int ai = 0; ai < 2; ++ai)
#pragma unroll
            for (int m = 0; m < 4; ++m) { bf16_t* rowp = base + (size_t)(row0 + ai * HALF + m * 16) * 1024 + col0;
#pragma unroll
                for (int bj = 0; bj < 2; ++bj) { f32x4 v0 = acc[ai][bj][m][0], v1 = acc[ai][bj][m][1];
#pragma unroll
                    for (int k = 0; k < 4; ++k) { v0[k] = sigmoidf_(v0[k]); v1[k] = sigmoidf_(v1[k]); }
                    st16(rowp + bj * HALF, pack8(v0, v1)); } }
    }
};
template <bool FIRST> struct EpiBranch {
    static constexpr bool PERM = true, AFTER_DRAIN = false;
    bf16_t* O; const bf16_t* G;
    __device__ __forceinline__ void operator()(const f32x4 (&acc)[2][2][4][2], const Unit& u, int wr, int wc, int fr, int fq) const {
        const int col0 = u.pn * BM + wc * 32 + 8 * fq, row0 = u.pm * BM + wr * 64 + fr;
#pragma unroll
        for (int ai = 0; ai < 2; ++ai)
#pragma unroll
            for (int m = 0; m < 4; ++m) { const size_t off = (size_t)(row0 + ai * HALF + m * 16) * 1024 + col0;
#pragma unroll
                for (int bj = 0; bj < 2; ++bj) { const u32x4 gw = *(const u32x4*)(G + off + bj * HALF);
                    f32x4 g0 = {bflo(gw.x), bfhi(gw.x), bflo(gw.y), bfhi(gw.y)}, g1 = {bflo(gw.z), bfhi(gw.z), bflo(gw.w), bfhi(gw.w)};
                    f32x4 v0 = acc[ai][bj][m][0] * g0, v1 = acc[ai][bj][m][1] * g1;
                    if (!FIRST) { const u32x4 ow = *(const u32x4*)(O + off + bj * HALF);
                        v0 += (f32x4){bflo(ow.x), bfhi(ow.x), bflo(ow.y), bfhi(ow.y)}; v1 += (f32x4){bflo(ow.z), bfhi(ow.z), bflo(ow.w), bfhi(ow.w)}; }
                    *(u32x4*)(O + off + bj * HALF) = pack8(v0, v1); } }
    }
};
struct EpiResid {
    static constexpr bool PERM = true, AFTER_DRAIN = false;
    const float* base; float* out; const float* gate; int lgS; int gstride;
    __device__ __forceinline__ void operator()(const f32x4 (&acc)[2][2][4][2], const Unit& u, int wr, int wc, int fr, int fq) const {
        const int col0 = u.pn * BM + wc * 32 + 8 * fq, row0 = u.pm * BM + wr * 64 + fr; const int b = (u.pm * BM) >> lgS;
        f32x4 gv[2][2];
#pragma unroll
        for (int bj = 0; bj < 2; ++bj)
#pragma unroll
            for (int n = 0; n < 2; ++n) gv[bj][n] = *(const f32x4*)(gate + (size_t)b * gstride + col0 + bj * HALF + 4 * n);
#pragma unroll
        for (int ai = 0; ai < 2; ++ai)
#pragma unroll
            for (int m = 0; m < 4; ++m) { const size_t off = (size_t)(row0 + ai * HALF + m * 16) * 1024 + col0;
#pragma unroll
                for (int bj = 0; bj < 2; ++bj)
#pragma unroll
                    for (int n = 0; n < 2; ++n) { const f32x4 bs = *(const f32x4*)(base + off + bj * HALF + 4 * n);
                        __builtin_nontemporal_store(bs + gv[bj][n] * acc[ai][bj][m][n], (f32x4*)(out + off + bj * HALF + 4 * n)); } }
    }
};
struct EpiSwiglu {
    static constexpr bool PERM = true, AFTER_DRAIN = false;
    bf16_t* O; int ldc;
    __device__ __forceinline__ void operator()(const f32x4 (&acc)[2][2][4][2], const Unit& u, int wr, int wc, int fr, int fq) const {
        const int col0 = u.pn * HALF + wc * 32 + 8 * fq, row0 = u.pm * BM + wr * 64 + fr;
#pragma unroll
        for (int ai = 0; ai < 2; ++ai)
#pragma unroll
            for (int m = 0; m < 4; ++m) { f32x4 v0, v1;
#pragma unroll
                for (int k = 0; k < 4; ++k) { const float g0 = acc[ai][0][m][0][k], g1 = acc[ai][0][m][1][k];
                    v0[k] = g0 * sigmoidf_(g0) * acc[ai][1][m][0][k]; v1[k] = g1 * sigmoidf_(g1) * acc[ai][1][m][1][k]; }
                *(u32x4*)(O + (size_t)(row0 + ai * HALF + m * 16) * ldc + col0) = pack8(v0, v1); }
    }
};

struct EpiResidNorm {
    static constexpr bool PERM = true, AFTER_DRAIN = false;
    const float* base; bf16_t* out; bf16_t* xg; float* ss; const float* gate; const float* g2; const float* sc2; int lgS; int gstride;
    __device__ __forceinline__ void operator()(const f32x4 (&acc)[2][2][4][2], const Unit& u, int wr, int wc, int fr, int fq) const {
        const int col0 = u.pn * BM + wc * 32 + 8 * fq, row0 = u.pm * BM + wr * 64 + fr; const int b = (u.pm * BM) >> lgS;
        f32x4 gv[2][2], gs[2][2];
#pragma unroll
        for (int bj = 0; bj < 2; ++bj)
#pragma unroll
            for (int n = 0; n < 2; ++n) { const int c = col0 + bj * HALF + 4 * n; gv[bj][n] = *(const f32x4*)(gate + (size_t)b * gstride + c);
                gs[bj][n] = *(const f32x4*)(g2 + c) * (*(const f32x4*)(sc2 + (size_t)b * gstride + c) + 1.0f); }
#pragma unroll
        for (int ai = 0; ai < 2; ++ai)
#pragma unroll
            for (int m = 0; m < 4; ++m) { const int row = row0 + ai * HALF + m * 16; const size_t off = (size_t)row * 1024 + col0; float sq = 0.f;
#pragma unroll
                for (int bj = 0; bj < 2; ++bj) { f32x4 x0 = *(const f32x4*)(base + off + bj * HALF), x1 = *(const f32x4*)(base + off + bj * HALF + 4);
                    x0 += gv[bj][0] * acc[ai][bj][m][0]; x1 += gv[bj][1] * acc[ai][bj][m][1];
                    st16(out + off + bj * HALF, pack8(x0, x1));
                    sq += (x0[0] * x0[0] + x0[1] * x0[1]) + (x0[2] * x0[2] + x0[3] * x0[3]) + (x1[0] * x1[0] + x1[1] * x1[1]) + (x1[2] * x1[2] + x1[3] * x1[3]);
                    *(u32x4*)(xg + off + bj * HALF) = pack8(x0 * gs[bj][0], x1 * gs[bj][1]);     }
                sq += __shfl_xor(sq, 16); sq += __shfl_xor(sq, 32);
                if (fq == 0) atomicAdd(ss + row, sq); }
    }
};
struct EpiSwigluNorm {
    static constexpr bool PERM = true, AFTER_DRAIN = false;
    bf16_t* O; int ldc; const float* ss; const float* c2; int lgS; int c2stride;
    __device__ __forceinline__ void operator()(const f32x4 (&acc)[2][2][4][2], const Unit& u, int wr, int wc, int fr, int fq) const {
        const int col0 = u.pn * HALF + wc * 32 + 8 * fq, row0 = u.pm * BM + wr * 64 + fr, wrow0 = u.pn * BM + wc * 32 + 8 * fq; const int b = (u.pm * BM) >> lgS;
        const float* cb = c2 + (size_t)b * c2stride + wrow0;
        const f32x4 cg0 = *(const f32x4*)(cb), cg1 = *(const f32x4*)(cb + 4), cu0 = *(const f32x4*)(cb + HALF), cu1 = *(const f32x4*)(cb + HALF + 4);
#pragma unroll
        for (int ai = 0; ai < 2; ++ai)
#pragma unroll
            for (int m = 0; m < 4; ++m) { const int row = row0 + ai * HALF + m * 16; const float rstd = rsqrtf(ss[row] * (1.0f / 1024.0f) + 1e-6f);
                const f32x4 g0 = acc[ai][0][m][0] * rstd + cg0, g1 = acc[ai][0][m][1] * rstd + cg1, u0 = acc[ai][1][m][0] * rstd + cu0, u1 = acc[ai][1][m][1] * rstd + cu1;
                f32x4 v0, v1;
#pragma unroll
                for (int k = 0; k < 4; ++k) { v0[k] = g0[k] * sigmoidf_(g0[k]) * u0[k]; v1[k] = g1[k] * sigmoidf_(g1[k]) * u1[k]; }
                *(u32x4*)(O + (size_t)row * ldc + col0) = pack8(v0, v1);     }
    }
};

struct EpiResidBf {
    static constexpr bool PERM = true, AFTER_DRAIN = false;
    const bf16_t* base; bf16_t* out; const float* gate; int lgS; int gstride;
    __device__ __forceinline__ void operator()(const f32x4 (&acc)[2][2][4][2], const Unit& u, int wr, int wc, int fr, int fq) const {
        const int col0 = u.pn * BM + wc * 32 + 8 * fq, row0 = u.pm * BM + wr * 64 + fr; const int b = (u.pm * BM) >> lgS;
        f32x4 gv[2][2];
#pragma unroll
        for (int bj = 0; bj < 2; ++bj)
#pragma unroll
            for (int n = 0; n < 2; ++n) gv[bj][n] = *(const f32x4*)(gate + (size_t)b * gstride + col0 + bj * HALF + 4 * n);
#pragma unroll
        for (int ai = 0; ai < 2; ++ai)
#pragma unroll
            for (int m = 0; m < 4; ++m) { const size_t off = (size_t)(row0 + ai * HALF + m * 16) * 1024 + col0;
#pragma unroll
                for (int bj = 0; bj < 2; ++bj) { const u32x4 bw = *(const u32x4*)(base + off + bj * HALF);
                    const f32x4 x0 = (f32x4){bflo(bw.x), bfhi(bw.x), bflo(bw.y), bfhi(bw.y)} + gv[bj][0] * acc[ai][bj][m][0];
                    const f32x4 x1 = (f32x4){bflo(bw.z), bfhi(bw.z), bflo(bw.w), bfhi(bw.w)} + gv[bj][1] * acc[ai][bj][m][1];
                    st16(out + off + bj * HALF, pack8(x0, x1)); } }
    }
};
template <class Epi, class Sched, bool ALIGN_EPI = false, bool SP2 = false>
__device__ __forceinline__ void gemm_phase(PG8_LAS unsigned char* lds, const Gemm g, const Sched& S, const Epi& E) {
    int tid_ = threadIdx.x; asm volatile("" : "+v"(tid_));
    const int tid = tid_, wid = __builtin_amdgcn_readfirstlane(tid >> 6), lane = tid & 63, wr = wid >> 2, wc = wid & 3, fr = lane & 15, fq = lane >> 4;
    const int K = g.K, nt = K / BK;
    unsigned voffA[2], voffB[2];
#pragma unroll
    for (int i = 0; i < 2; ++i) { int R, C; stage_rc(tid * 16 + i * 8192, R, C); const int Rb = Epi::PERM ? ((R & ~31) + perm32(R & 31)) : R;
        voffA[i] = (unsigned)(R * K + C) * 2u; voffB[i] = (unsigned)(Rb * K + C) * 2u; }
    const size_t kstep = (size_t)(BK * 2);
    const size_t hstep = (size_t)HALF * K * 2;
    const size_t tstep = 2 * hstep;
    const unsigned ldsw = (unsigned)wid * 1024u;
    const int aoff = lds_byte(wr * 64 + fr, fq * 8), boff = lds_byte(wc * 32 + fr, fq * 8);
#define PG8_SA(b, h) (((b) * 2 + (h)) * HTB)
#define PG8_SB(b, h) ((4 + (b) * 2 + (h)) * HTB)
#define PG8_STAGE(bufoff, gbase, voff) do { _Pragma("unroll") for (int _i = 0; _i < 2; ++_i) \
        __builtin_amdgcn_global_load_lds((const unsigned*)((const char*)(gbase) + (voff)[_i]), (PG8_LAS unsigned*)(lds + (bufoff) + ldsw + _i * 8192), 16, 0, 0); } while (0)
#define PG8_LDA(dst, b, h) do { _Pragma("unroll") for (int m = 0; m < 4; ++m) _Pragma("unroll") for (int k = 0; k < 2; ++k) dst[m][k] = *(const PG8_LAS bf16x8*)(lds + PG8_SA(b, h) + aoff + m * 2048 + k * 1024); } while (0)
#define PG8_LDB(dst, b, h) do { _Pragma("unroll") for (int n = 0; n < 2; ++n) _Pragma("unroll") for (int k = 0; k < 2; ++k) dst[n][k] = *(const PG8_LAS bf16x8*)(lds + PG8_SB(b, h) + boff + n * 2048 + k * 1024); } while (0)
#define PG8_MMA(ai, bj, At, Bt) do { __builtin_amdgcn_s_setprio(1); _Pragma("unroll") for (int m = 0; m < 4; ++m) _Pragma("unroll") for (int n = 0; n < 2; ++n) _Pragma("unroll") for (int k = 0; k < 2; ++k) \
        acc[ai][bj][m][n] = __builtin_amdgcn_mfma_f32_16x16x32_bf16(Bt[n][k], At[m][k], acc[ai][bj][m][n], 0, 0, 0); __builtin_amdgcn_s_setprio(0); } while (0)
#define PG8_WAIT_V(n) asm volatile("s_waitcnt vmcnt(" #n ")" ::: "memory")
#define PG8_WAIT_L(n) asm volatile("s_waitcnt lgkmcnt(" #n ")" ::: "memory")
#define PG8_BAR __builtin_amdgcn_s_barrier()
#define PG8_SCHED __builtin_amdgcn_sched_barrier(0)
    Unit cur, nxt; int ui = 0;
    if (!S.next(0, cur)) return;
    f32x4 acc[2][2][4][2];
#pragma unroll
    for (int a = 0; a < 2; ++a)
#pragma unroll
        for (int b = 0; b < 2; ++b)
#pragma unroll
            for (int m = 0; m < 4; ++m)
#pragma unroll
                for (int n = 0; n < 2; ++n) acc[a][b][m][n] = (f32x4){0.f, 0.f, 0.f, 0.f};
    bf16x8 At[4][2], B0[2][2], B1[2][2];
    const char* cA = (const char*)g.A + (size_t)cur.pm * tstep; const char* cB = (const char*)g.Bt + (size_t)cur.pn * tstep;
    S.a_ready(cur);
    if constexpr (SP2) {
        PG8_STAGE(PG8_SB(0, 0), cB, voffB); PG8_STAGE(PG8_SB(0, 1), cB + hstep, voffB); PG8_STAGE(PG8_SA(0, 0), cA, voffA); PG8_STAGE(PG8_SA(0, 1), cA + hstep, voffA);
        if (wr == 1) PG8_BAR;
        PG8_WAIT_V(2); PG8_BAR;
        PG8_STAGE(PG8_SB(1, 0), cB + kstep, voffB); PG8_STAGE(PG8_SA(1, 0), cA + kstep, voffA); PG8_STAGE(PG8_SB(1, 1), cB + hstep + kstep, voffB);
        PG8_WAIT_V(6); PG8_BAR;
    } else {
        PG8_STAGE(PG8_SB(0, 0), cB, voffB); PG8_STAGE(PG8_SA(0, 0), cA, voffA); PG8_STAGE(PG8_SB(0, 1), cB + hstep, voffB); PG8_STAGE(PG8_SA(0, 1), cA + hstep, voffA);
        if (wr == 1) PG8_BAR;
        PG8_WAIT_V(4); PG8_BAR;
        PG8_STAGE(PG8_SB(1, 0), cB + kstep, voffB); PG8_STAGE(PG8_SA(1, 0), cA + kstep, voffA); PG8_STAGE(PG8_SB(1, 1), cB + hstep + kstep, voffB);
        PG8_WAIT_V(6); PG8_BAR;
    }
    for (;;) {
        const bool has_next = S.next(ui + 1, nxt);
        const char* nA = has_next ? (const char*)g.A + (size_t)nxt.pm * tstep : cA; const char* nB = has_next ? (const char*)g.Bt + (size_t)nxt.pn * tstep : cB;
        for (int t = 0; t < nt; t += 2) {
            const bool last = (t == nt - 2);
            const char* a1 = cA + (size_t)(t + 1) * kstep;
            const char* a2 = last ? nA : cA + (size_t)(t + 2) * kstep; const char* b2 = last ? nB : cB + (size_t)(t + 2) * kstep;
            const char* a3 = a2 + kstep; const char* b3 = b2 + kstep;
            if (last && has_next) S.a_ready(nxt);
            if constexpr (SP2) {
            PG8_LDB(B0, 0, 0); PG8_LDB(B1, 0, 1); PG8_SCHED; PG8_LDA(At, 0, 0); PG8_STAGE(PG8_SA(1, 1), a1 + hstep, voffA);
            PG8_WAIT_V(8); PG8_WAIT_L(0); PG8_BAR; PG8_MMA(0, 0, At, B0); PG8_MMA(0, 1, At, B1); PG8_BAR; PG8_SCHED;
            PG8_LDA(At, 0, 1); PG8_STAGE(PG8_SB(0, 0), b2, voffB); PG8_STAGE(PG8_SB(0, 1), b2 + hstep, voffB); PG8_STAGE(PG8_SA(0, 0), a2, voffA);
            PG8_WAIT_V(8); PG8_WAIT_L(0); PG8_BAR; PG8_MMA(1, 0, At, B0); PG8_MMA(1, 1, At, B1); PG8_BAR; PG8_SCHED;
            PG8_LDB(B0, 1, 0); PG8_LDB(B1, 1, 1); PG8_SCHED; PG8_LDA(At, 1, 0); PG8_STAGE(PG8_SA(0, 1), a2 + hstep, voffA);
            PG8_WAIT_V(8); PG8_WAIT_L(0); PG8_BAR; PG8_MMA(0, 0, At, B0); PG8_MMA(0, 1, At, B1); PG8_BAR; PG8_SCHED;
            PG8_LDA(At, 1, 1); PG8_STAGE(PG8_SB(1, 0), b3, voffB); PG8_STAGE(PG8_SB(1, 1), b3 + hstep, voffB); PG8_STAGE(PG8_SA(1, 0), a3, voffA);
            PG8_WAIT_V(8); PG8_WAIT_L(0); PG8_BAR; PG8_MMA(1, 0, At, B0); PG8_MMA(1, 1, At, B1); PG8_BAR; PG8_SCHED;
            } else {
            PG8_LDB(B0, 0, 0); PG8_SCHED; PG8_LDA(At, 0, 0); PG8_STAGE(PG8_SA(1, 1), a1 + hstep, voffA);
            PG8_WAIT_L(8); PG8_BAR; PG8_WAIT_L(0); PG8_MMA(0, 0, At, B0); PG8_BAR; PG8_SCHED;
            PG8_LDB(B1, 0, 1); PG8_STAGE(PG8_SB(0, 0), b2, voffB);
            PG8_BAR; PG8_WAIT_L(0); PG8_MMA(0, 1, At, B1); PG8_BAR;
            PG8_LDA(At, 0, 1); PG8_STAGE(PG8_SA(0, 0), a2, voffA);
            PG8_BAR; PG8_WAIT_L(0); PG8_MMA(1, 0, At, B0); PG8_BAR; PG8_SCHED;
            PG8_STAGE(PG8_SB(0, 1), b2 + hstep, voffB);
            PG8_WAIT_V(6); PG8_BAR; PG8_MMA(1, 1, At, B1); PG8_BAR;
            PG8_LDB(B0, 1, 0); PG8_SCHED; PG8_LDA(At, 1, 0); PG8_STAGE(PG8_SA(0, 1), a2 + hstep, voffA);
            PG8_WAIT_L(8); PG8_BAR; PG8_WAIT_L(0); PG8_MMA(0, 0, At, B0); PG8_BAR; PG8_SCHED;
            PG8_LDB(B1, 1, 1); PG8_STAGE(PG8_SB(1, 0), b3, voffB);
            PG8_BAR; PG8_WAIT_L(0); PG8_MMA(0, 1, At, B1); PG8_BAR;
            PG8_LDA(At, 1, 1); PG8_STAGE(PG8_SA(1, 0), a3, voffA);
            PG8_BAR; PG8_WAIT_L(0); PG8_MMA(1, 0, At, B0); PG8_BAR; PG8_SCHED;
            PG8_STAGE(PG8_SB(1, 1), b3 + hstep, voffB);
            PG8_WAIT_V(6); PG8_BAR; PG8_MMA(1, 1, At, B1); PG8_BAR;
            }
        }
        if constexpr (ALIGN_EPI) { if (wr == 0) PG8_BAR; }
        if constexpr (!Epi::AFTER_DRAIN) { E(acc, cur, wr, wc, fr, fq); S.done(cur); }
        if (!has_next) break;
#pragma unroll
        for (int a = 0; a < 2; ++a)
#pragma unroll
            for (int b = 0; b < 2; ++b)
#pragma unroll
                for (int m = 0; m < 4; ++m)
#pragma unroll
                    for (int n = 0; n < 2; ++n) acc[a][b][m][n] = (f32x4){0.f, 0.f, 0.f, 0.f};
        cur = nxt; cA = nA; cB = nB; ++ui;
        if constexpr (ALIGN_EPI) { if (wr == 1) PG8_BAR; }
    }
    PG8_WAIT_V(0);
    if constexpr (!ALIGN_EPI) { if (wr == 0) PG8_BAR; }
    PG8_BAR;
    if constexpr (Epi::AFTER_DRAIN) { E.fused(acc, cur, wr, wc, fr, fq, lds, wid, lane); S.done(cur); }
#undef PG8_SA
#undef PG8_SB
#undef PG8_STAGE
#undef PG8_LDA
#undef PG8_LDB
#undef PG8_MMA
#undef PG8_WAIT_V
#undef PG8_WAIT_L
#undef PG8_BAR
#undef PG8_SCHED
}
}

constexpr int DM = 1024, NHALF = 32768  , DFF = 2816, NMOD = 6144;
constexpr int NIN_A = 6656  , NIN_MG = 2048;
constexpr int NWAVES = 8, NTHREADS = 512;
constexpr float EPS = 1e-6f;
typedef unsigned short bf16_t;
typedef float f32x4 __attribute__((ext_vector_type(4)));
typedef float f32x16 __attribute__((ext_vector_type(16)));
typedef unsigned u32x4 __attribute__((ext_vector_type(4)));
typedef unsigned u32x2 __attribute__((ext_vector_type(2)));
typedef short bf16x8 __attribute__((ext_vector_type(8)));
typedef short s16x4 __attribute__((ext_vector_type(4)));
#define LAS __attribute__((address_space(3)))
using pg8::pk2; using pg8::bflo; using pg8::bfhi; using pg8::fexp2; using pg8::frcp; using pg8::sigmoidf_; using pg8::pack8;

constexpr size_t MiB = 1u << 20;
constexpr size_t WS_WIN = 0, WS_WFI = 17 * MiB, WS_WFO = 28 * MiB, WS_WBR = 34 * MiB, WS_WOUT = 36 * MiB, WS_WBA = 38 * MiB, WS_RGW = 39 * MiB;
constexpr size_t WS_MOD = 39 * MiB + 512 * 1024, WS_ROPE = 40 * MiB, WS_SP = 40 * MiB + 512 * 1024, WS_SUMM = 41 * MiB, WS_CARRY = 45 * MiB;
constexpr size_t WS_H1 = 48 * MiB;
constexpr size_t WS_XR = 112 * MiB;
constexpr size_t WS_Q = 176 * MiB;
constexpr size_t WS_PF = 176 * MiB, WS_PB = 304 * MiB, WS_ATT = 432 * MiB, WS_MGR = 112 * MiB, WS_MRG = 176 * MiB;
constexpr size_t WS_K = 272 * MiB;
constexpr size_t WS_V = 368 * MiB;
constexpr size_t WS_RNN = 48 * MiB;
constexpr size_t WS_BAR = 47 * MiB, BAR_BYTES = 16384;
constexpr size_t WS_SS = 47 * MiB + 65536  , WS_C2 = 47 * MiB + 262144  ;
constexpr size_t WS_AO2 = 464 * MiB, WS_LSE = 496 * MiB, WS_END = 499 * MiB;
constexpr size_t WS_HID = 240 * MiB;

constexpr int LDS_BYTES = 147456;

struct Params { const float* in[22]; float* out; unsigned char* ws; };

__device__ __forceinline__ float wave_sum(float v) {
#pragma unroll
    for (int o = 1; o < 64; o <<= 1) v += __shfl_xor(v, o);
    return v;
}

__device__ __forceinline__ void transpose_item(const float* W, int K, int N, bf16_t* WT, int k0, int n0, int dst_row0, LAS float* scr, int lane, float wscale = 1.0f, bool perm16 = false) {
    f32x4 t[8];
#pragma unroll
    for (int i = 0; i < 8; ++i) { const int kk = 8 * i + (lane >> 3); t[i] = *(const f32x4*)(W + (size_t)(k0 + kk) * N + n0 + 4 * (lane & 7)); }
#pragma unroll
    for (int i = 0; i < 8; ++i) { const int kk = 8 * i + (lane >> 3); LAS float* d = scr + kk * 33 + 4 * (lane & 7);
        d[0] = wscale * t[i].x; d[1] = wscale * t[i].y; d[2] = wscale * t[i].z; d[3] = wscale * t[i].w; }
    asm volatile("s_waitcnt lgkmcnt(0)" ::: "memory");
    const int c = lane & 7;
#pragma unroll
    for (int j = 0; j < 4; ++j) { const int n = (lane >> 3) + 8 * j; const LAS float* s = scr + (8 * c) * 33 + n;
        u32x4 o; o.x = pk2(s[0 * 33], s[1 * 33]); o.y = pk2(s[2 * 33], s[3 * 33]); o.z = pk2(s[4 * 33], s[5 * 33]); o.w = pk2(s[6 * 33], s[7 * 33]);
        const int nd = (perm16 && n < 16) ? ((n & 3) | ((n & 4) << 1) | ((n & 8) >> 1)) : n;
        *(u32x4*)(WT + (size_t)(dst_row0 + nd) * K + k0 + 8 * c) = o; }
    asm volatile("s_waitcnt lgkmcnt(0)" ::: "memory");
}
__device__ __forceinline__ void transpose_plain(const float* W, int K, int N, bf16_t* WT, int item, LAS float* scr, int lane) {
    const int nblk = N / 32, kb = item / nblk, nb = item % nblk; transpose_item(W, K, N, WT, 64 * kb, 32 * nb, 32 * nb, scr, lane);
}

#define BAR_LDS() asm volatile("s_waitcnt lgkmcnt(0)\n\ts_barrier" ::: "memory")
#define LAUNDER_TID() int tid_ = threadIdx.x; asm volatile("" : "+v"(tid_)); const int tid = tid_, lane = tid & 63, wave = __builtin_amdgcn_readfirstlane(tid >> 6); (void)lane; (void)wave
__device__ __forceinline__ void phase0(const Params& p, LAS unsigned char* lds) {
    LAUNDER_TID();
    unsigned char* ws = p.ws;
    const int G = gridDim.x;
    if (blockIdx.x < 96) {
        LAS float* sc = (LAS float*)lds;
        LAS float* red = (LAS float*)(lds + 49152);
        for (int i = tid; i < 12 * 1024; i += NTHREADS) { const int b = i >> 10, k = i & 1023; const float c = (b < 4) ? p.in[2][b * 1024 + k] : p.in[3][(b - 4) * 1024 + k]; sc[i] = c * sigmoidf_(c); }
        __syncthreads();
        const float* wada = p.in[4]; const int j = blockIdx.x * 64 + lane, kbeg = wave * 128;
        float acc[12];
#pragma unroll
        for (int b = 0; b < 12; ++b) acc[b] = 0.f;
#pragma unroll 16
        for (int kk = 0; kk < 128; ++kk) { const float w = wada[(size_t)(kbeg + kk) * NMOD + j];
#pragma unroll
            for (int b = 0; b < 12; ++b) acc[b] += sc[b * 1024 + kbeg + kk] * w; }
#pragma unroll
        for (int b = 0; b < 12; ++b) red[(wave * 12 + b) * 64 + lane] = acc[b];
        __syncthreads();
        float* mod = (float*)(ws + WS_MOD);
        for (int i = tid; i < 12 * 64; i += NTHREADS) { const int b = i >> 6, l = i & 63; float s = p.in[5][blockIdx.x * 64 + l];
#pragma unroll
            for (int w = 0; w < 8; ++w) s += red[(w * 12 + b) * 64 + l];
            mod[b * NMOD + blockIdx.x * 64 + l] = s; }
        __syncthreads();
    }
    const int gt = blockIdx.x * NTHREADS + tid, NGT = G * NTHREADS;
    { float* rope = (float*)(ws + WS_ROPE);
      for (int i = gt; i < 8192 * 8; i += NGT) { const int t = i >> 3, f = i & 7; const float inv = exp2f(-(float)f * 0.125f * 18.931568569324174f);
          const float ang = (float)t * inv; rope[2 * i] = cosf(ang); rope[2 * i + 1] = sinf(ang); }
      float* sp = (float*)(ws + WS_SP);
      for (int i = gt; i < 2048; i += NGT) { const float lam = p.in[14][i]; sp[i] = -8.0f * 1.4426950408889634f * log1pf(expf(-lam)); }
    }
    LAS float* scr = (LAS float*)(lds + wave * 16384);
    const int gw = blockIdx.x * NWAVES + wave, NGW = G * NWAVES;
    constexpr int I_IN = 16 * 272, I_BR = 16 * 32, I_BA = 8 * 32, I_OUT = 16 * 32, I_FI = 16 * 176, I_FO = 44 * 32, I_RG = 128;
    constexpr int NITEMS = I_IN + I_BR + I_BA + I_OUT + I_FI + I_FO + I_RG;
    const bool split = (G > 96) && (96 * NWAVES * 2 < NITEMS);
    const int modw = 96 * NWAVES, first = split ? ((blockIdx.x < 96) ? gw : 2 * modw + (gw - modw)) : gw;
    const int step = split ? ((blockIdx.x < 96) ? modw : (NGW - modw)) : NGW, last = (split && blockIdx.x < 96) ? 2 * modw : NITEMS;
    for (int it = first; it < last; it += step) {
        int r = it;
        if (r < I_IN) { const int kb = r / 272, nb = r % 272, n0 = 32 * nb; const bool rot = (n0 >= 2048) && (n0 < 5120) && ((n0 & 63) == 0);
            transpose_item(p.in[7], 1024, 8704, (bf16_t*)(ws + WS_WIN), 64 * kb, n0, n0, scr, lane, 1.0f, rot); continue; } r -= I_IN;
        if (r < I_BR) { transpose_plain(p.in[15], 1024, 1024, (bf16_t*)(ws + WS_WBR), r, scr, lane); continue; } r -= I_BR;
        if (r < I_BA) { transpose_plain(p.in[16], 512, 1024, (bf16_t*)(ws + WS_WBA), r, scr, lane); continue; } r -= I_BA;
        if (r < I_OUT) { transpose_plain(p.in[17], 1024, 1024, (bf16_t*)(ws + WS_WOUT), r, scr, lane); continue; } r -= I_OUT;
        if (r < I_FI) { const int kb = r / 176, nb = r % 176, n0 = 32 * nb; const int jj = (n0 < DFF) ? n0 : n0 - DFF;
            const int dst = 256 * (jj >> 7) + (jj & 127) + ((n0 < DFF) ? 0 : 128);
            transpose_item(p.in[19], 1024, 2 * DFF, (bf16_t*)(ws + WS_WFI), 64 * kb, n0, dst, scr, lane); continue; } r -= I_FI;
        if (r < I_FO) { transpose_plain(p.in[20], DFF, 1024, (bf16_t*)(ws + WS_WFO), r, scr, lane); continue; } r -= I_FO;
        { const int mat = r >> 1, nb = r & 1, gate = mat >> 5, dn = mat & 31;
          const float* src = (gate ? p.in[12] : p.in[10]) + (size_t)dn * 4096; const int dir = dn >> 4, n = dn & 15;
          bf16_t* dst = (bf16_t*)(ws + WS_RGW) + (size_t)(((dir * 2 + gate) * 16 + n)) * 4096;
          transpose_item(src, 64, 64, dst, 0, 32 * nb, 32 * nb, scr, lane, -1.4426950408889634f); }
    }
}

__device__ __forceinline__ void rownorm_mod(const float* src, bf16_t* dst, const float* g, const float* mod, int sh_off, int sc_off, int lgS, int bbase, float* ss_zero) {
    LAUNDER_TID();
    const int gw = blockIdx.x * NWAVES + wave, NGW = gridDim.x * NWAVES;
    for (int row0 = 2 * gw; row0 < NHALF; row0 += 2 * NGW) {
        f32x4 v[2][4]; float s[2];
#pragma unroll
        for (int q = 0; q < 2; ++q) { const f32x4* xr = (const f32x4*)(src + (size_t)(row0 + q) * DM) + lane;
#pragma unroll
            for (int j = 0; j < 4; ++j) v[q][j] = xr[64 * j]; }
#pragma unroll
        for (int q = 0; q < 2; ++q) { float t = 0.f;
#pragma unroll
            for (int j = 0; j < 4; ++j) t += (v[q][j].x * v[q][j].x + v[q][j].y * v[q][j].y) + (v[q][j].z * v[q][j].z + v[q][j].w * v[q][j].w);
            s[q] = t; }
#pragma unroll
        for (int o = 1; o < 64; o <<= 1) { s[0] += __shfl_xor(s[0], o); s[1] += __shfl_xor(s[1], o); }
        const float* mb = mod + (size_t)(bbase + (row0 >> lgS)) * NMOD;
        if (lane < 2) ss_zero[row0 + lane] = 0.f;
#pragma unroll
        for (int q = 0; q < 2; ++q) { const float rstd = rsqrtf(s[q] * (1.f / DM) + EPS);
            u32x2* o8 = (u32x2*)(dst + (size_t)(row0 + q) * DM) + lane;
#pragma unroll
            for (int j = 0; j < 4; ++j) { const int idx = 4 * lane + 256 * j;
                const f32x4 gg = *(const f32x4*)(g + idx), sc = *(const f32x4*)(mb + sc_off + idx), sh = *(const f32x4*)(mb + sh_off + idx);
                const f32x4 o = v[q][j] * rstd * gg * (sc + 1.0f) + sh;
                u32x2 w; w.x = pk2(o.x, o.y); w.y = pk2(o.z, o.w); o8[64 * j] = w; } }
    }
}
__device__ __forceinline__ void rownorm_final(const bf16_t* src, float* dst, const float* g) {
    LAUNDER_TID();
    const int gw = blockIdx.x * NWAVES + wave, NGW = gridDim.x * NWAVES;
    const f32x4 g0 = *(const f32x4*)(g + 8 * lane), g1 = *(const f32x4*)(g + 8 * lane + 4), g2 = *(const f32x4*)(g + 512 + 8 * lane), g3 = *(const f32x4*)(g + 512 + 8 * lane + 4);
    for (int row0 = 2 * gw; row0 < NHALF; row0 += 2 * NGW) {
        u32x4 w[2][2]; float s[2];
#pragma unroll
        for (int q = 0; q < 2; ++q) { const u32x4* xr = (const u32x4*)(src + (size_t)(row0 + q) * DM) + lane; w[q][0] = xr[0]; w[q][1] = xr[64]; }
        f32x4 v[2][4];
#pragma unroll
        for (int q = 0; q < 2; ++q) {
#pragma unroll
            for (int j = 0; j < 2; ++j) { v[q][2 * j] = (f32x4){bflo(w[q][j].x), bfhi(w[q][j].x), bflo(w[q][j].y), bfhi(w[q][j].y)}; v[q][2 * j + 1] = (f32x4){bflo(w[q][j].z), bfhi(w[q][j].z), bflo(w[q][j].w), bfhi(w[q][j].w)}; }
            float t = 0.f;
#pragma unroll
            for (int j = 0; j < 4; ++j) t += (v[q][j].x * v[q][j].x + v[q][j].y * v[q][j].y) + (v[q][j].z * v[q][j].z + v[q][j].w * v[q][j].w);
            s[q] = t; }
#pragma unroll
        for (int o = 1; o < 64; o <<= 1) { s[0] += __shfl_xor(s[0], o); s[1] += __shfl_xor(s[1], o); }
#pragma unroll
        for (int q = 0; q < 2; ++q) { const float rstd = rsqrtf(s[q] * (1.f / DM) + EPS);
            f32x4* orow = (f32x4*)(dst + (size_t)(row0 + q) * DM) + 2 * lane;
            __builtin_nontemporal_store(v[q][0] * rstd * g0, orow); __builtin_nontemporal_store(v[q][1] * rstd * g1, orow + 1);
            __builtin_nontemporal_store(v[q][2] * rstd * g2, orow + 128); __builtin_nontemporal_store(v[q][3] * rstd * g3, orow + 129); }
    }
}

__device__ __forceinline__ void compute_c2(const Params& p) {
    LAUNDER_TID();
    const bf16_t* WT = (const bf16_t*)(p.ws + WS_WFI); const float* mod = (const float*)(p.ws + WS_MOD); float* C2 = (float*)(p.ws + WS_C2);
    const int gw = blockIdx.x * NWAVES + wave, NGW = gridDim.x * NWAVES;
    for (int n = gw; n < 2 * DFF; n += NGW) {
        const u32x4 w0 = *(const u32x4*)(WT + (size_t)n * DM + 16 * lane), w1 = *(const u32x4*)(WT + (size_t)n * DM + 16 * lane + 8);
        const float wf[16] = {bflo(w0.x), bfhi(w0.x), bflo(w0.y), bfhi(w0.y), bflo(w0.z), bfhi(w0.z), bflo(w0.w), bfhi(w0.w), bflo(w1.x), bfhi(w1.x), bflo(w1.y), bfhi(w1.y), bflo(w1.z), bfhi(w1.z), bflo(w1.w), bfhi(w1.w)};
        float mine = 0.f;
#pragma unroll
        for (int b = 0; b < 12; ++b) { const f32x4* sh = (const f32x4*)(mod + (size_t)b * NMOD + 3072 + 16 * lane); float s = 0.f;
#pragma unroll
            for (int q = 0; q < 4; ++q) { const f32x4 t = sh[q]; s += (t.x * wf[4 * q] + t.y * wf[4 * q + 1]) + (t.z * wf[4 * q + 2] + t.w * wf[4 * q + 3]); }
            s = wave_sum(s); if (lane == b) mine = s; }
        if (lane < 12) C2[(size_t)lane * (2 * DFF) + n] = mine;
    }
}

#define MFMA32(a, b, c) __builtin_amdgcn_mfma_f32_32x32x16_bf16((a), (b), (c), 0, 0, 0)
__device__ __forceinline__ int crow(int reg, int h) { return (reg & 3) + 8 * (reg >> 2) + 4 * h; }
typedef short v4i16_t __attribute__((ext_vector_type(4)));
__device__ __forceinline__ s16x4 vtr(const LAS unsigned char* p) { return __builtin_bit_cast(s16x4, __builtin_amdgcn_ds_read_tr16_b64_v4i16((LAS v4i16_t*)p)); }
constexpr int AK_PITCH = 144, AK_BYTES = 384 * AK_PITCH, AV_HALF = 384 * 64, ATT_WSF = AK_BYTES + 2 * AV_HALF;

__device__ __forceinline__ void attn_load(const bf16_t* Kg, const bf16_t* Vg, int v, int L, u32x4 (&kr)[6], u32x4 (&vr)[6], int tid) {
    const int rho0 = 256 * v, m0 = rho0 & (L - 1);
#pragma unroll
    for (int it = 0; it < 6; ++it) { const int idx = it * NTHREADS + tid, kk = idx >> 3, c = idx & 7, m = m0 - 64 + kk; const bool ok = (m >= 0) && (m < L);
        const size_t off = ok ? ((size_t)(rho0 - 64 + kk) * 64 + c * 8) : 0;
        u32x4 kv = *(const u32x4*)(Kg + off), vv = *(const u32x4*)(Vg + off);
        if (!ok) { kv = (u32x4){0u, 0u, 0u, 0u}; vv = kv; }
        kr[it] = kv; vr[it] = vv; }
}
__device__ __forceinline__ void attn_loadq(const bf16_t* Qg, int v, bf16x8 (&q)[4], int lane, int wave) {
    const bf16_t* qp = Qg + (size_t)(256 * v + 32 * wave + (lane & 31)) * 64 + 8 * (lane >> 5);
#pragma unroll
    for (int d0 = 0; d0 < 4; ++d0) q[d0] = *(const bf16x8*)(qp + 16 * d0);
}
__device__ __forceinline__ void attn_unit(LAS unsigned char* lds, bf16_t* AOg, float* LSEg, int v, int L, int dsh, int S,
                                          u32x4 (&kr)[6], u32x4 (&vr)[6], bf16x8 (&qnext)[4], int tid, int lane, int wave, const bf16_t* Qf, const bf16_t* Kf, const bf16_t* Vf, int un) {
    const int r = lane & 31, h = lane >> 5;
    const int rho0 = 256 * v, m0 = rho0 & (L - 1), sigma = rho0 / L;
    LAS unsigned char* Ks = lds; LAS unsigned char* Vs = lds + AK_BYTES; LAS float* wsf = (LAS float*)(lds + ATT_WSF) + wave * 32;
#pragma unroll
    for (int it = 0; it < 6; ++it) { const int idx = it * NTHREADS + tid, kk = idx >> 3, c = idx & 7;
        *(LAS u32x4*)(Ks + kk * AK_PITCH + c * 16) = kr[it]; *(LAS u32x4*)(Vs + (c >> 2) * AV_HALF + kk * 64 + (c & 3) * 16) = vr[it]; }
    bf16x8 qr[4];
#pragma unroll
    for (int d0 = 0; d0 < 4; ++d0) qr[d0] = qnext[d0];
    BAR_LDS();
    if (un < 3072) { const int gn = un >> 10; attn_load(Kf + (size_t)gn * 262144 * 64, Vf + (size_t)gn * 262144 * 64, un & 1023, S >> (2 * gn), kr, vr, tid);
        attn_loadq(Qf + (size_t)gn * 262144 * 64, un & 1023, qnext, lane, wave); }
    f32x16 p[5]; float mx = -INFINITY;
#pragma unroll
    for (int j = 0; j < 5; ++j) {
        const int mlo = m0 + 32 * wave - 64 + 32 * j; const bool tv = (mlo >= 0) && (mlo + 32 <= L);
        f32x16 a = {};
        const LAS unsigned char* kp = Ks + (32 * wave + 32 * j + r) * AK_PITCH + h * 16;
#pragma unroll
        for (int d0 = 0; d0 < 4; ++d0) { const bf16x8 kf = *(const LAS bf16x8*)(kp + d0 * 32); a = MFMA32(kf, qr[d0], a); }
#pragma unroll
        for (int i = 0; i < 16; ++i) { const int key = crow(i, h); bool ok = tv; if (j == 0) ok = ok && (key >= r); if (j == 4) ok = ok && (key <= r);
            const float s = ok ? a[i] : -INFINITY; p[j][i] = s; mx = fmaxf(mx, s); }
    }
    mx = fmaxf(mx, __shfl_xor(mx, 32));
    float l = 0.f;
#pragma unroll
    for (int j = 0; j < 5; ++j)
#pragma unroll
        for (int i = 0; i < 16; ++i) { const float e = fexp2(p[j][i] - mx); p[j][i] = e; l += e; }
    l += __shfl_xor(l, 32);
    f32x16 o0 = {}, o1 = {};
    const LAS unsigned char* vb = Vs + ((lane >> 4) & 1) * 32 + (lane & 3) * 8 + (4 * h + ((lane & 15) >> 2)) * 64 + (32 * wave) * 64;
#pragma unroll
    for (int j = 0; j < 5; ++j)
#pragma unroll
        for (int s = 0; s < 2; ++s) {
            u32x4 pw; pw.x = pk2(p[j][8 * s + 0], p[j][8 * s + 1]); pw.y = pk2(p[j][8 * s + 2], p[j][8 * s + 3]); pw.z = pk2(p[j][8 * s + 4], p[j][8 * s + 5]); pw.w = pk2(p[j][8 * s + 6], p[j][8 * s + 7]);
            const bf16x8 pa = __builtin_bit_cast(bf16x8, pw);
            const LAS unsigned char* vp = vb + (32 * j + 16 * s) * 64;
            const s16x4 lo0 = vtr(vp), hi0 = vtr(vp + 512), lo1 = vtr(vp + AV_HALF), hi1 = vtr(vp + AV_HALF + 512);
            const bf16x8 vf0 = __builtin_shufflevector(lo0, hi0, 0, 1, 2, 3, 4, 5, 6, 7), vf1 = __builtin_shufflevector(lo1, hi1, 0, 1, 2, 3, 4, 5, 6, 7);
            o0 = MFMA32(pa, vf0, o0); o1 = MFMA32(pa, vf1, o1);
        }
#pragma unroll
    for (int it = 0; it < 6; ++it) asm volatile("" : "+v"(kr[it]), "+v"(vr[it]));
#pragma unroll
    for (int d0 = 0; d0 < 4; ++d0) asm volatile("" : "+v"(qnext[d0]));
    const float rl = frcp(l);
    if (h == 0) wsf[r] = rl;
    const int dil = 1 << dsh, rr = sigma & (dil - 1), bh = sigma >> dsh, hh = bh & 7, b = bh >> 3;
    if (h == 0) { const int mq = m0 + 32 * wave + r; const int tok = b * S + (mq << dsh) + rr; LSEg[(size_t)tok * 8 + hh] = mx + __log2f(l); }
#pragma unroll
    for (int i = 0; i < 16; ++i) { const int q = crow(i, h); const float sc = wsf[q]; const int mq = m0 + 32 * wave + q; const int tok = b * S + (mq << dsh) + rr;
        bf16_t* op = AOg + (size_t)tok * 512 + hh * 64 + r;
        __builtin_nontemporal_store((bf16_t)(pk2(o0[i] * sc, 0.f) & 0xffffu), op); __builtin_nontemporal_store((bf16_t)(pk2(o1[i] * sc, 0.f) & 0xffffu), op + 32); }
    BAR_LDS();
}


__device__ __forceinline__ void attn_phase(LAS unsigned char* lds, const bf16_t* Qf, const bf16_t* Kf, const bf16_t* Vf, bf16_t* AO0, bf16_t* AO1, bf16_t* AO2, float* LSE, int S) {
    LAUNDER_TID();
    const int G = gridDim.x; constexpr size_t GS = (size_t)262144 * 64;
    u32x4 kr[6], vr[6]; bf16x8 qn[4];
    int u = blockIdx.x;
    if (u < 3072) { const int g = u >> 10; attn_load(Kf + g * GS, Vf + g * GS, u & 1023, S >> (2 * g), kr, vr, tid); attn_loadq(Qf + g * GS, u & 1023, qn, lane, wave); }
    else {
#pragma unroll
        for (int d0 = 0; d0 < 4; ++d0) qn[d0] = (bf16x8){0, 0, 0, 0, 0, 0, 0, 0}; }
    for (; u < 3072; u += G) { const int g = u >> 10, v = u & 1023, dsh = 2 * g;
        bf16_t* AOg = (g == 0) ? AO0 : (g == 1 ? AO1 : AO2);
        attn_unit(lds, AOg, LSE + (size_t)g * NHALF * 8, v, S >> dsh, dsh, S, kr, vr, qn, tid, lane, wave, Qf, Kf, Vf, u + G); }
}

__device__ __forceinline__ void attn_merge(const bf16_t* AO0, const bf16_t* AO1, const bf16_t* AO2, const float* LSE, bf16_t* ATT) {
    LAUNDER_TID();
    const int gt = blockIdx.x * NTHREADS + tid, NGT = gridDim.x * NTHREADS;
    for (int idx0 = gt; idx0 < NHALF * 64; idx0 += 2 * NGT) {
        u32x4 a[2], b[2], c[2]; float l0[2], l1[2], l2[2]; size_t off[2];
#pragma unroll
        for (int q = 0; q < 2; ++q) { int idx = idx0 + q * NGT; if (idx >= NHALF * 64) idx = NHALF * 64 - 1; const int tok = idx >> 6, c8 = idx & 63, hh = c8 >> 3;
            l0[q] = LSE[(size_t)tok * 8 + hh]; l1[q] = LSE[(size_t)NHALF * 8 + (size_t)tok * 8 + hh]; l2[q] = LSE[(size_t)2 * NHALF * 8 + (size_t)tok * 8 + hh];
            off[q] = (size_t)tok * 512 + c8 * 8; a[q] = *(const u32x4*)(AO0 + off[q]); b[q] = *(const u32x4*)(AO1 + off[q]); c[q] = *(const u32x4*)(AO2 + off[q]); }
#pragma unroll
        for (int q = 0; q < 2; ++q) { if (idx0 + q * NGT >= NHALF * 64) continue;
            const float mx = fmaxf(l0[q], fmaxf(l1[q], l2[q])); float w0 = fexp2(l0[q] - mx), w1 = fexp2(l1[q] - mx), w2 = fexp2(l2[q] - mx); const float inv = frcp(w0 + w1 + w2); w0 *= inv; w1 *= inv; w2 *= inv;
            const u32x4 A = a[q], B = b[q], C = c[q]; u32x4 o;
            o.x = pk2(w0 * bflo(A.x) + w1 * bflo(B.x) + w2 * bflo(C.x), w0 * bfhi(A.x) + w1 * bfhi(B.x) + w2 * bfhi(C.x));
            o.y = pk2(w0 * bflo(A.y) + w1 * bflo(B.y) + w2 * bflo(C.y), w0 * bfhi(A.y) + w1 * bfhi(B.y) + w2 * bfhi(C.y));
            o.z = pk2(w0 * bflo(A.z) + w1 * bflo(B.z) + w2 * bflo(C.z), w0 * bfhi(A.z) + w1 * bfhi(B.z) + w2 * bfhi(C.z));
            o.w = pk2(w0 * bflo(A.w) + w1 * bflo(B.w) + w2 * bflo(C.w), w0 * bfhi(A.w) + w1 * bfhi(B.w) + w2 * bfhi(C.w));
            *(u32x4*)(ATT + off[q]) = o; }
    }
}

constexpr int XC_PITCH = 136  ;
__device__ __forceinline__ float fsqrt_(float x) { return __builtin_amdgcn_sqrtf(x); }

template <int DIR>
__device__ __forceinline__ void rnn_wave(const LAS bf16_t* XC, unsigned* PD  , int loff  ,
                                         const bf16x8 (&wr_)[4], const bf16x8 (&wi_)[4], float bR, float bI, float c1, float& Aout, float& Bout, int colbase, int r, int h) {
    float c = 0.f, Pc = 1.f;
#pragma unroll 1
    for (int it = 0; it < 4; ++it) {
        const int tt = DIR ? 3 - it : it;
        f32x16 aR, aI;
#pragma unroll
        for (int i = 0; i < 16; ++i) { aR[i] = bR; aI[i] = bI; }
#pragma unroll
        for (int ks = 0; ks < 4; ++ks) { const bf16x8 xa = *(const LAS bf16x8*)(XC + (32 * tt + r) * XC_PITCH + (colbase & 64) + 16 * ks + 8 * h);
            aR = MFMA32(xa, wr_[ks], aR); aI = MFMA32(xa, wi_[ks], aI); }
        float a[16], u[16];
#pragma unroll
        for (int i = 0; i < 16; ++i) { const float xv = bflo((unsigned)XC[(32 * tt + crow(i, h)) * XC_PITCH + colbase + r]);
            const float rg = frcp(1.0f + fexp2(aR[i])), ig = frcp(1.0f + fexp2(aI[i])); const float av = fexp2(rg * c1);
            a[i] = av; u[i] = fsqrt_(1.0f - av * av) * (ig * xv); }
        float Ag[4], Bg[4], pA[4], pB[4];
#pragma unroll
        for (int g = 0; g < 4; ++g) {
            if (DIR == 0) { float A = a[4 * g], B = u[4 * g];
#pragma unroll
                for (int i = 1; i < 4; ++i) { B = B * a[4 * g + i] + u[4 * g + i]; A *= a[4 * g + i]; }
                Ag[g] = A; Bg[g] = B; }
            else { float A = a[4 * g + 3], B = u[4 * g + 3];
#pragma unroll
                for (int i = 2; i >= 0; --i) { B = B * a[4 * g + i] + u[4 * g + i]; A *= a[4 * g + i]; }
                Ag[g] = A; Bg[g] = B; }
            pA[g] = __shfl_xor(Ag[g], 32); pB[g] = __shfl_xor(Bg[g], 32);
        }
        float cown[4], pown[4];
#pragma unroll
        for (int kk = 0; kk < 8; ++kk) { const int k = DIR ? 7 - kk : kk; const int g = k >> 1, hh = k & 1; const bool mine = (hh == h);
            const float A = mine ? Ag[g] : pA[g], B = mine ? Bg[g] : pB[g];
            if (mine) { cown[g] = c; pown[g] = Pc; }
            c = A * c + B; Pc *= A; }
#pragma unroll
        for (int g = 0; g < 4; ++g) { float hp = cown[g], pp = pown[g];
#pragma unroll
            for (int ii = 0; ii < 4; ++ii) { const int i = DIR ? 3 - ii : ii; hp = a[4 * g + i] * hp + u[4 * g + i]; pp *= a[4 * g + i];
                unsigned* rowp = PD + (size_t)(32 * tt + crow(4 * g + i, 0)) * DM;
                __builtin_nontemporal_store(pk2(hp, pp), rowp + loff); } }
    }
    Aout = Pc; Bout = c;
}

__device__ __forceinline__ void rnn_fetch(const bf16_t* XR, int item, int S, int tid, u32x4 (&xw)[7]) {
    const int ci = item >> 3, np = item & 7, tok0 = ci * 128, t0 = tok0 & (S - 1), c8 = tid & 15, tg = tid >> 4, ch = 128 * np + 8 * c8;
#pragma unroll
    for (int j = 0; j < 7; ++j) { const int tk = 4 * tg + j - 2, ts = t0 + tk; const bool ok = (ts >= 0) && (ts < S); const int rowc = ok ? (tok0 + tk) : tok0;
        xw[j] = *(const u32x4*)(XR + (size_t)rowc * DM + ch); if (!ok) xw[j] = (u32x4){0u, 0u, 0u, 0u}; }
}
constexpr int RNN_CW_OFF = 40960;
__device__ __forceinline__ void rnn_pass1(const Params& p, LAS unsigned char* lds, const bf16_t* XR, unsigned* PF, unsigned* PB, int S) {
    LAUNDER_TID();
    unsigned char* ws = p.ws;
    LAS bf16_t* XC = (LAS bf16_t*)lds; LAS float* CW = (LAS float*)(lds + RNN_CW_OFF);
    const float* convw = p.in[8]; const float* convb = p.in[9];
    const int r = lane & 31, h = lane >> 5, rb = wave >> 2, chalf = (wave >> 1) & 1, dir = wave & 1, colbase = 64 * rb + 32 * chalf;
    float* SUMM = (float*)(ws + WS_SUMM);
    const int NITEM = 256 * 8, G = gridDim.x;
    int item = blockIdx.x, np_cur = -1;
    u32x4 xw[7];
    bf16x8 wr_[4], wi_[4]; float bR = 0.f, bI = 0.f, c1 = 0.f;
#pragma unroll
    for (int ks = 0; ks < 4; ++ks) { wr_[ks] = (bf16x8){0, 0, 0, 0, 0, 0, 0, 0}; wi_[ks] = wr_[ks]; }
    if (item < NITEM) rnn_fetch(XR, item, S, tid, xw);
    for (; item < NITEM; item += G) {
        const int ci = item >> 3, np = item & 7, tok0 = ci * 128;
        const int n = 2 * np + rb, d = 32 * chalf + r, chg = 64 * n + d;
        if (np != np_cur) {
            np_cur = np;
            for (int i = tid; i < 640; i += NTHREADS) CW[i] = (i < 512) ? convw[(i >> 7) * DM + 128 * np + (i & 127)] : convb[128 * np + (i - 512)];
            const bf16_t* gr = (const bf16_t*)(ws + WS_RGW) + (size_t)(((dir * 2 + 0) * 16 + n) * 64 + d) * 64 + 8 * h; const bf16_t* gi = gr + (size_t)16 * 4096;
#pragma unroll
            for (int ks = 0; ks < 4; ++ks) { wr_[ks] = *(const bf16x8*)(gr + 16 * ks); wi_[ks] = *(const bf16x8*)(gi + 16 * ks); }
            bR = -1.4426950408889634f * p.in[11][dir * 1024 + chg]; bI = -1.4426950408889634f * p.in[13][dir * 1024 + chg]; c1 = ((const float*)(ws + WS_SP))[dir * 1024 + chg];
            __syncthreads();
        }
        { const int c8 = tid & 15, tg = tid >> 4;
          float xf[7][8];
#pragma unroll
          for (int j = 0; j < 7; ++j) { xf[j][0] = bflo(xw[j].x); xf[j][1] = bfhi(xw[j].x); xf[j][2] = bflo(xw[j].y); xf[j][3] = bfhi(xw[j].y); xf[j][4] = bflo(xw[j].z); xf[j][5] = bfhi(xw[j].z); xf[j][6] = bflo(xw[j].w); xf[j][7] = bfhi(xw[j].w); }
          float o[4][8];
          { const f32x4 b0 = *(const LAS f32x4*)(CW + 512 + 8 * c8), b1 = *(const LAS f32x4*)(CW + 512 + 8 * c8 + 4);
#pragma unroll
            for (int q = 0; q < 4; ++q) { o[q][0] = b0.x; o[q][1] = b0.y; o[q][2] = b0.z; o[q][3] = b0.w; o[q][4] = b1.x; o[q][5] = b1.y; o[q][6] = b1.z; o[q][7] = b1.w; } }
#pragma unroll
          for (int k = 0; k < 4; ++k) { const f32x4 w0 = *(const LAS f32x4*)(CW + k * 128 + 8 * c8), w1 = *(const LAS f32x4*)(CW + k * 128 + 8 * c8 + 4);
              const float wk[8] = {w0.x, w0.y, w0.z, w0.w, w1.x, w1.y, w1.z, w1.w};
#pragma unroll
              for (int q = 0; q < 4; ++q)
#pragma unroll
                  for (int e = 0; e < 8; ++e) o[q][e] += xf[q + k][e] * wk[e]; }
#pragma unroll
          for (int q = 0; q < 4; ++q) { u32x4 w; w.x = pk2(o[q][0], o[q][1]); w.y = pk2(o[q][2], o[q][3]); w.z = pk2(o[q][4], o[q][5]); w.w = pk2(o[q][6], o[q][7]);
              *(LAS u32x4*)(XC + (4 * tg + q) * XC_PITCH + 8 * c8) = w; } }
        BAR_LDS();
        if (item + G < NITEM) rnn_fetch(XR, item + G, S, tid, xw);
        float Ao, Bo;
        if (dir == 0) rnn_wave<0>(XC, PF + (size_t)tok0 * DM, chg + 4 * h * DM, wr_, wi_, bR, bI, c1, Ao, Bo, colbase, r, h);
        else          rnn_wave<1>(XC, PB + (size_t)tok0 * DM, chg + 4 * h * DM, wr_, wi_, bR, bI, c1, Ao, Bo, colbase, r, h);
        if (h == 0) { float* sp = SUMM + (((size_t)ci * 2 + dir) * 1024 + chg) * 2; sp[0] = Ao; sp[1] = Bo; }
        BAR_LDS();
    }
}

__device__ __forceinline__ void rnn_pass2(const Params& p, const unsigned* PF, const unsigned* PB, const bf16_t* GRG, bf16_t* RNN) {
    LAUNDER_TID();
    const float* CARRY = (const float*)(p.ws + WS_CARRY);
    const int gt = blockIdx.x * NTHREADS + tid, NGT = gridDim.x * NTHREADS;
    for (int idx = gt; idx < NHALF * 128; idx += NGT) { const int tok = idx >> 7, ch = (idx & 127) * 8, ci = tok >> 7;
        const size_t off = (size_t)tok * DM + ch;
        const u32x4 f0 = *(const u32x4*)(PF + off), f1 = *(const u32x4*)(PF + off + 4), b0 = *(const u32x4*)(PB + off), b1 = *(const u32x4*)(PB + off + 4);
        const f32x4 cf0 = *(const f32x4*)(CARRY + ((size_t)ci * 2 + 0) * 1024 + ch), cf1 = *(const f32x4*)(CARRY + ((size_t)ci * 2 + 0) * 1024 + ch + 4);
        const f32x4 cb0 = *(const f32x4*)(CARRY + ((size_t)ci * 2 + 1) * 1024 + ch), cb1 = *(const f32x4*)(CARRY + ((size_t)ci * 2 + 1) * 1024 + ch + 4);
        const u32x4 gw = *(const u32x4*)(GRG + off);
        float v[8];
        v[0] = bflo(f0.x) + bfhi(f0.x) * cf0.x + bflo(b0.x) + bfhi(b0.x) * cb0.x; v[1] = bflo(f0.y) + bfhi(f0.y) * cf0.y + bflo(b0.y) + bfhi(b0.y) * cb0.y;
        v[2] = bflo(f0.z) + bfhi(f0.z) * cf0.z + bflo(b0.z) + bfhi(b0.z) * cb0.z; v[3] = bflo(f0.w) + bfhi(f0.w) * cf0.w + bflo(b0.w) + bfhi(b0.w) * cb0.w;
        v[4] = bflo(f1.x) + bfhi(f1.x) * cf1.x + bflo(b1.x) + bfhi(b1.x) * cb1.x; v[5] = bflo(f1.y) + bfhi(f1.y) * cf1.y + bflo(b1.y) + bfhi(b1.y) * cb1.y;
        v[6] = bflo(f1.z) + bfhi(f1.z) * cf1.z + bflo(b1.z) + bfhi(b1.z) * cb1.z; v[7] = bflo(f1.w) + bfhi(f1.w) * cf1.w + bflo(b1.w) + bfhi(b1.w) * cb1.w;
        using pg8::gelu_tanh;
        u32x4 o; o.x = pk2(v[0] * gelu_tanh(bflo(gw.x)), v[1] * gelu_tanh(bfhi(gw.x))); o.y = pk2(v[2] * gelu_tanh(bflo(gw.y)), v[3] * gelu_tanh(bfhi(gw.y))); o.z = pk2(v[4] * gelu_tanh(bflo(gw.z)), v[5] * gelu_tanh(bfhi(gw.z))); o.w = pk2(v[6] * gelu_tanh(bflo(gw.w)), v[7] * gelu_tanh(bfhi(gw.w)));
        *(u32x4*)(RNN + off) = o; }
}

template <int NC>
__device__ __forceinline__ void carry_scan_t(const float* SUMM, float* CARRY, int nseq, int tid) {
    const int gt = blockIdx.x * NTHREADS + tid, NGT = gridDim.x * NTHREADS;
    for (int idx = gt; idx < nseq * 2048; idx += NGT) { const int seq = idx >> 11, dir = (idx >> 10) & 1, ch = idx & 1023;
        const size_t o0 = ((size_t)(seq * NC + (dir ? NC - 1 : 0)) * 2 + dir) * 1024 + ch; const long step = dir ? -2048 : 2048;
        float2 ab[NC];
#pragma unroll
        for (int k = 0; k < NC; ++k) ab[k] = *(const float2*)(SUMM + (o0 + k * step) * 2);
        float c = 0.f;
#pragma unroll
        for (int k = 0; k < NC; ++k) { CARRY[o0 + k * step] = c; c = ab[k].x * c + ab[k].y; }
    }
}
__device__ __forceinline__ void carry_scan(const Params& p, int S, int nseq) {
    LAUNDER_TID();
    const float* SUMM = (const float*)(p.ws + WS_SUMM); float* CARRY = (float*)(p.ws + WS_CARRY);
    if (S == 8192) carry_scan_t<64>(SUMM, CARRY, nseq, tid); else carry_scan_t<32>(SUMM, CARRY, nseq, tid);
}

#define XB_TMO      128
#define XB_XCNT(j)  (256  + 64 * (j))
#define XB_XSUB(j)  (1280 + 64 * (j))
#define XB_XGEN(j)  (2304 + 64 * (j))
#define XB_TOP      3328
#define XB_TOPGEN   3392
#define XCD_BAR_WORDS 3456
#define XB_SPIN_CAP (1u << 18)

__device__ __forceinline__ unsigned xb_ld(unsigned* p)              { return __hip_atomic_load(p, __ATOMIC_RELAXED, __HIP_MEMORY_SCOPE_AGENT); }
__device__ __forceinline__ unsigned xb_add(unsigned* p, unsigned v) { return __hip_atomic_fetch_add(p, v, __ATOMIC_RELAXED, __HIP_MEMORY_SCOPE_AGENT); }
__device__ __forceinline__ unsigned xb_xcc_id() { return (unsigned)__builtin_amdgcn_s_getreg((3 << 11) | 20) & 0xFu; }
#define XB_SPIN(cond, bar) do { unsigned _sp = 0; while (cond) { __builtin_amdgcn_s_sleep(1); \
    if ((++_sp & 255u) == 0u) { if (xb_ld(&(bar)[XB_TMO])) break; if (_sp > XB_SPIN_CAP) { atomicAdd(&(bar)[XB_TMO], 1u); break; } } } } while (0)

struct XcdBarrier {
    unsigned* bar; unsigned x;
    volatile LAS unsigned* st;
};

__device__ __forceinline__ XcdBarrier xcd_barrier_post(unsigned* bar, volatile LAS unsigned* st) {
    XcdBarrier b; b.bar = bar; b.x = xb_xcc_id(); b.st = st;
    if (threadIdx.x == 0) (void)xb_add(&bar[XB_XCNT(b.x)], 1u);
    return b;
}
__device__ __forceinline__ void xcd_barrier_complete(unsigned* bar, unsigned x, unsigned& nloc, unsigned& nx) {
    const unsigned G = gridDim.x * gridDim.y * gridDim.z;
    unsigned sum, cnt, mine, sp = 0u;
    for (;;) {
        sum = 0u; cnt = 0u; mine = 0u;
#pragma unroll
        for (unsigned j = 0; j < 16; ++j) { const unsigned c = xb_ld(&bar[XB_XCNT(j)]); sum += c; cnt += (c > 0u) ? 1u : 0u; mine = (j == x) ? c : mine; }
        if (sum == G) break;
        __builtin_amdgcn_s_sleep(1);
        if ((++sp & 255u) == 0u) { if (xb_ld(&bar[XB_TMO])) break; if (sp > XB_SPIN_CAP) { atomicAdd(&bar[XB_TMO], 1u); break; } }
    }
    nloc = mine > 0u ? mine : 1u; nx = cnt > 0u ? cnt : 1u;
}

__device__ __forceinline__ void xcd_barrier(const XcdBarrier& b) {
    asm volatile("s_waitcnt vmcnt(0)" ::: "memory");
    __syncthreads();
    if (threadIdx.x == 0) {
        unsigned* bar = b.bar; const unsigned bx_ = xb_xcc_id();
        __builtin_amdgcn_s_waitcnt(0);
        unsigned nloc = b.st[0], nx = b.st[1];
        if (nloc == 0u) { xcd_barrier_complete(bar, bx_, nloc, nx); b.st[0] = nloc; b.st[1] = nx; }
        const unsigned old = xb_add(&bar[XB_XSUB(bx_)], 1u);
        const unsigned gen = old / nloc;
        if (old + 1u == (gen + 1u) * nloc) {
            __builtin_amdgcn_fence(__ATOMIC_RELEASE, "agent");
            asm volatile("s_waitcnt vmcnt(0)" ::: "memory");
            const unsigned og = xb_add(&bar[XB_TOP], 1u);
            const unsigned tg = og / nx;
            if (og + 1u == (tg + 1u) * nx) xb_add(&bar[XB_TOPGEN], 1u);
            else XB_SPIN(xb_ld(&bar[XB_TOPGEN]) == tg, bar);
            __builtin_amdgcn_fence(__ATOMIC_ACQUIRE, "agent");
            xb_add(&bar[XB_XGEN(bx_)], 1u);
            asm volatile("s_waitcnt vmcnt(0)" ::: "memory");
        } else {
            XB_SPIN(xb_ld(&bar[XB_XGEN(bx_)]) == gen, bar);
            __builtin_amdgcn_fence(__ATOMIC_ACQUIRE, "agent");
            asm volatile("s_waitcnt vmcnt(0)" ::: "memory");
        }
    }
    __syncthreads();
}

#define GAS __attribute__((address_space(1)))
#define PHASE_PTRS() GAS unsigned char* wsg_ = (GAS unsigned char*)ws_; asm volatile("" : "+s"(wsg_)); unsigned char* ws = (unsigned char*)wsg_; GAS float* dog_ = (GAS float*)dout_; asm volatile("" : "+s"(dog_)); float* dout = (float*)dog_;     const float* mod = (const float*)(ws + WS_MOD); \
bf16_t* H1 = (bf16_t*)(ws + WS_H1); bf16_t* XR = (bf16_t*)(ws + WS_XR); bf16_t* GRG = (bf16_t*)dout; \
        bf16_t* Qf = (bf16_t*)(ws + WS_Q); bf16_t* Kf = (bf16_t*)(ws + WS_K); bf16_t* Vf = (bf16_t*)(ws + WS_V); \
        bf16_t* AO0 = (bf16_t*)((unsigned char*)dout + 64 * MiB); bf16_t* AO1 = (bf16_t*)((unsigned char*)dout + 96 * MiB); bf16_t* AO2 = (bf16_t*)(ws + WS_AO2); \
        float* LSE = (float*)(ws + WS_LSE); \
        unsigned* PF = (unsigned*)(ws + WS_PF); unsigned* PB = (unsigned*)(ws + WS_PB); \
        bf16_t* ATT = (bf16_t*)(ws + WS_ATT); bf16_t* MGR = (bf16_t*)(ws + WS_MGR); bf16_t* MGA = (bf16_t*)((unsigned char*)dout + 64 * MiB); bf16_t* RNN = (bf16_t*)(ws + WS_RNN); \
        bf16_t* MRG = (bf16_t*)(ws + WS_MRG); bf16_t* H2 = (bf16_t*)(ws + WS_H1); bf16_t* HID = (bf16_t*)(ws + WS_HID); \
        bf16_t* X1B = (bf16_t*)(ws + WS_XR); bf16_t* X2B = (bf16_t*)(ws + WS_MRG);
__global__ void __launch_bounds__(NTHREADS, 2) fwd_megakernel(Params p) {
    extern __shared__ __attribute__((aligned(16))) unsigned char lds_raw[];
    LAS unsigned char* lds = (LAS unsigned char*)lds_raw;
    cg::grid_group grid = cg::this_grid();
    volatile LAS unsigned* MISC = (volatile LAS unsigned*)(lds + 131072);
    if (threadIdx.x < 64) MISC[threadIdx.x] = 0u;
    __syncthreads();
    const XcdBarrier xbar = xcd_barrier_post((unsigned*)(p.ws + WS_BAR), MISC + 8);
    unsigned char* ws_ = p.ws;
    const int G = gridDim.x, bx = blockIdx.x;

#ifndef PHMASK
#define PHMASK 0xffff
#endif
#define EN(k) ((PHMASK >> (k)) & 1)
#ifndef REP_GEMM
#define REP_GEMM 1
#endif
#ifndef REP_OTHER
#define REP_OTHER 1
#endif
#define RG for (int rep_ = 0; rep_ < REP_GEMM; ++rep_)
#define RO for (int rep_ = 0; rep_ < REP_OTHER; ++rep_)
#ifndef REP_ATT
#define REP_ATT 1
#endif
#ifndef REP_RNN
#define REP_RNN 1
#endif
#define RA for (int rep_ = 0; rep_ < REP_ATT; ++rep_)
#define RR for (int rep_ = 0; rep_ < REP_RNN; ++rep_)
    if (EN(0)) phase0(p, lds);
    if (p.ws == nullptr) grid.sync();
    xcd_barrier(xbar);

    for (int half = 0; half < 2; ++half) {
        const int S = half ? 4096 : 8192, lgS = half ? 12 : 13, nseq = half ? 8 : 4, bbase = half ? 4 : 0;
        const float* xin = p.in[half];
        float* dout_ = p.out + (size_t)half * NHALF * DM;
        { PHASE_PTRS();
        if (half == 0) compute_c2(p);
        RO if (EN(1)) rownorm_mod(xin, H1, p.in[6], mod, 0, 1024, lgS, bbase, (float*)(ws + WS_SS));
        }
        xcd_barrier(xbar);
        { PHASE_PTRS();
        RG if (EN(2)) { pg8::Gemm g{H1, (const bf16_t*)(ws + WS_WIN), NHALF, NIN_A, DM}; pg8::StaticOrder So; So.init(NHALF, NIN_A, G, bx);
          pg8::EpiInProj E{XR, GRG, Qf, (size_t)(WS_K - WS_Q) / 2, (const float*)(ws + WS_ROPE), S, lgS};
          static_assert(WS_V - WS_K == WS_K - WS_Q, "q/k/v equally spaced");
          pg8::gemm_phase<pg8::EpiInProj, pg8::StaticOrder, true, true>(lds, g, So, E); }
        }
        xcd_barrier(xbar);
        { PHASE_PTRS();
        RA if (EN(3)) attn_phase(lds, Qf, Kf, Vf, AO0, AO1, AO2, LSE, S);
        }
        xcd_barrier(xbar);
        { PHASE_PTRS();
        RR if (EN(4)) rnn_pass1(p, lds, XR, PF, PB, S);
        RO if (EN(5)) attn_merge(AO0, AO1, AO2, LSE, ATT);
        }
        xcd_barrier(xbar);
        { PHASE_PTRS();
        RO if (EN(5)) carry_scan(p, S, nseq);
        RG if (EN(6)) { pg8::Gemm g{H1, (const bf16_t*)(ws + WS_WIN) + (size_t)NIN_A * DM, NHALF, NIN_MG, DM}; pg8::StaticOrder So; So.init(NHALF, NIN_MG, G, bx);
          pg8::EpiMg E{MGR, MGA};
          pg8::gemm_phase<pg8::EpiMg, pg8::StaticOrder, true, true>(lds, g, So, E); }
        }
        xcd_barrier(xbar);
        { PHASE_PTRS();
        RO if (EN(7)) rnn_pass2(p, PF, PB, GRG, RNN);
        }
        xcd_barrier(xbar);
        { PHASE_PTRS();
        RG if (EN(8)) { pg8::Gemm g{RNN, (const bf16_t*)(ws + WS_WBR), NHALF, DM, DM}; pg8::StaticOrder So; So.init(NHALF, DM, G, bx);
          pg8::EpiBranch<true> E{MRG, MGR};
          pg8::gemm_phase<pg8::EpiBranch<true>, pg8::StaticOrder, true, true>(lds, g, So, E); }
        if (EN(9)) { pg8::Gemm g{ATT, (const bf16_t*)(ws + WS_WBA), NHALF, DM, 512}; pg8::StaticOrder So; So.init(NHALF, DM, G, bx);
          pg8::EpiBranch<false> E{MRG, MGA};
          pg8::gemm_phase<pg8::EpiBranch<false>, pg8::StaticOrder, true, true>(lds, g, So, E); }
        }
        xcd_barrier(xbar);
        { PHASE_PTRS();
        if (EN(10)) { pg8::Gemm g{MRG, (const bf16_t*)(ws + WS_WOUT), NHALF, DM, DM}; pg8::StaticOrder So; So.init(NHALF, DM, G, bx);
          pg8::EpiResidNorm E{xin, X1B, H2, (float*)(ws + WS_SS), mod + (size_t)bbase * NMOD + 2048, p.in[18], mod + (size_t)bbase * NMOD + 4096, lgS, NMOD};
          pg8::gemm_phase<pg8::EpiResidNorm, pg8::StaticOrder, true, true>(lds, g, So, E); }
        }
        xcd_barrier(xbar);
        { PHASE_PTRS();
        RG if (EN(12)) { pg8::Gemm g{H2, (const bf16_t*)(ws + WS_WFI), NHALF, 2 * DFF, DM}; pg8::StaticOrder So; So.init(NHALF, 2 * DFF, G, bx);
          pg8::EpiSwigluNorm E{HID, DFF, (const float*)(ws + WS_SS), (const float*)(ws + WS_C2) + (size_t)bbase * (2 * DFF), lgS, 2 * DFF};
          pg8::gemm_phase<pg8::EpiSwigluNorm, pg8::StaticOrder, true, true>(lds, g, So, E); }
        }
        xcd_barrier(xbar);
        { PHASE_PTRS();
        if (EN(13)) { pg8::Gemm g{HID, (const bf16_t*)(ws + WS_WFO), NHALF, DM, DFF}; pg8::StaticOrder So; So.init(NHALF, DM, G, bx);
          pg8::EpiResidBf E{X1B, X2B, mod + (size_t)bbase * NMOD + 5120, lgS, NMOD};
          pg8::gemm_phase<pg8::EpiResidBf, pg8::StaticOrder, true, true>(lds, g, So, E); }
        }
        xcd_barrier(xbar);
        { PHASE_PTRS();
        if (EN(14)) rownorm_final(X2B, dout, p.in[21]);
        }
    }
}

extern "C" void kernel_launch(void* const* d_in, const int* in_sizes, int n_in, void* d_out, int out_size, void* d_ws, size_t ws_size, hipStream_t stream) {
    static int grid = 0;
    if (grid == 0) {
        if (n_in != 22 || out_size != 2 * NHALF * DM || ws_size < WS_END) { fprintf(stderr, "kernel_launch: unexpected shapes (n_in %d out %d ws %zu)\n", n_in, out_size, ws_size); grid = -1; return; }
        int dev = 0, cus = 0, per_cu = 0;
        (void)hipGetDevice(&dev); (void)hipDeviceGetAttribute(&cus, hipDeviceAttributeMultiprocessorCount, dev);
        if (hipFuncSetAttribute((const void*)fwd_megakernel, hipFuncAttributeMaxDynamicSharedMemorySize, LDS_BYTES) != hipSuccess) { fprintf(stderr, "kernel_launch: hipFuncSetAttribute failed\n"); grid = -1; return; }
        if (hipOccupancyMaxActiveBlocksPerMultiprocessor(&per_cu, (const void*)fwd_megakernel, NTHREADS, LDS_BYTES) != hipSuccess || per_cu < 1) per_cu = 1;
        (void)hipGetLastError();
        grid = cus * per_cu;
    }
    if (grid < 0) return;
    Params prm{};
    for (int i = 0; i < 22; ++i) prm.in[i] = (const float*)d_in[i];
    prm.out = (float*)d_out; prm.ws = (unsigned char*)d_ws;
    if (hipMemsetAsync((char*)d_ws + WS_BAR, 0, BAR_BYTES, stream) != hipSuccess) { fprintf(stderr, "kernel_launch: memset of the barrier words failed\n"); return; }
    void* args[] = {&prm};
    hipError_t e = hipLaunchCooperativeKernel((const void*)fwd_megakernel, dim3(grid), dim3(NTHREADS), args, LDS_BYTES, stream);
    if (e != hipSuccess) fprintf(stderr, "cooperative launch failed: %s (grid %d)\n", hipGetErrorString(e), grid);
}
```
